# Optimizing an MI355X kernel written in HIP

```python
import jax, jax.numpy as jnp
from jax import lax
import numpy as np

D_MODEL = 2048
BATCH = 4
SEQ = 4096
DEPTH = 4

N_A_LAYERS = DEPTH // 2
N_B_LAYERS = DEPTH - N_A_LAYERS
D_FF = 5632
GMLP_CHUNK = 128
GMLP_D_GATE = D_MODEL
GMLP_GROUP_WIDTH = 128
GMLP_GROUPS = GMLP_D_GATE // GMLP_GROUP_WIDTH
HEAD_DIM = 128
N_HEADS = D_MODEL // HEAD_DIM
DILATED_GROUPS = ((128, 1), (512, 4), (2048, 16))
N_GROUPS = len(DILATED_GROUPS)
ATTN_BLOCK = 128
REL_WINDOW = 128
EPS = 1e-6

kernel_name = "yoco_gmlp_dilated_alibi_macaron"


def rms_norm(x, g):
    xf = x.astype(jnp.float32)
    y = xf * lax.rsqrt(jnp.mean(xf * xf, axis=-1, keepdims=True) + EPS)
    return (y * g.astype(jnp.float32)).astype(x.dtype)


def swiglu(h, w_gate, w_up, w_down):
    return (jax.nn.silu(h @ w_gate) * (h @ w_up)) @ w_down


def gmlp_mixer(h, w_in, v_norm, w_s, b_s, w_out):
    bsz, seq, _ = h.shape
    z = jax.nn.gelu(h @ w_in)
    u, v = z[..., :GMLP_D_GATE], z[..., GMLP_D_GATE:]
    v = rms_norm(v, v_norm)
    v = v.reshape(bsz, seq // GMLP_CHUNK, GMLP_CHUNK, GMLP_GROUPS, GMLP_GROUP_WIDTH)
    causal = jnp.tril(jnp.ones((GMLP_CHUNK, GMLP_CHUNK), dtype=w_s.dtype))
    ws = w_s * causal[None]
    sv = jnp.einsum('gpq,bnqgc->bnpgc', ws, v) + b_s.T[None, None, :, :, None]
    return (u * sv.reshape(bsz, seq, GMLP_D_GATE)) @ w_out


def dilated_branch(q, k, v, dil, slopes):
    bsz, seq, nh, dh = q.shape
    L = seq // dil
    n = bsz * dil

    def to_sub(t):
        t = t.reshape(bsz, L, dil, nh, dh).transpose(0, 2, 1, 3, 4)
        return t.reshape(n, L, nh, dh)

    def from_sub(t):
        rest = t.shape[2:]
        t = t.reshape((bsz, dil, L) + rest)
        t = jnp.swapaxes(t, 1, 2)
        return t.reshape((bsz, seq) + rest)

    nb = -(-L // ATTN_BLOCK)
    Lp = nb * ATTN_BLOCK
    pad = Lp - L
    qs = jnp.pad(to_sub(q), ((0, 0), (0, pad), (0, 0), (0, 0))).reshape(n, nb, ATTN_BLOCK, nh, dh)

    def band(t):
        tp = jnp.pad(to_sub(t), ((0, 0), (ATTN_BLOCK, pad), (0, 0), (0, 0)))
        prev = tp[:, :Lp].reshape(n, nb, ATTN_BLOCK, nh, dh)
        cur = tp[:, ATTN_BLOCK:].reshape(n, nb, ATTN_BLOCK, nh, dh)
        return jnp.concatenate([prev, cur], axis=2)

    kb, vb = band(k), band(v)
    s = jnp.einsum('nbqhd,nbkhd->nbhqk', qs, kb, preferred_element_type=jnp.float32)
    qi = jnp.arange(ATTN_BLOCK)[:, None]
    kj = jnp.arange(2 * ATTN_BLOCK)[None, :]
    delta = qi + ATTN_BLOCK - kj
    j_abs = jnp.arange(nb)[:, None, None] * ATTN_BLOCK - ATTN_BLOCK + kj[None]
    valid = (delta >= 0)[None] & (delta <= REL_WINDOW)[None] & (j_abs >= 0)
    alibi = -slopes[:, None, None] * (delta * dil).astype(jnp.float32)[None]
    s = jnp.where(valid[None, :, None], s + alibi[None, None], -jnp.inf)
    m = jnp.max(s, axis=-1, keepdims=True)
    p = jnp.exp(s - m)
    l = jnp.sum(p, axis=-1, keepdims=True)
    o = jnp.einsum('nbhqk,nbkhd->nbqhd', p / l, vb.astype(jnp.float32))
    lse = (m + jnp.log(l))[..., 0]
    lse = lse.transpose(0, 1, 3, 2).reshape(n, Lp, nh)[:, :L]
    o = o.reshape(n, Lp, nh, dh)[:, :L]
    return from_sub(o), from_sub(lse)


def dilated_mixer(h, k_sh, v_sh, w_q, q_norm, w_o, slopes):
    bsz, seq, _ = h.shape
    q = (h @ w_q).reshape(bsz, seq, N_GROUPS, N_HEADS, HEAD_DIM)
    q = rms_norm(q, q_norm[:, None, :]) * (HEAD_DIM ** -0.5)
    outs, lses = [], []
    for g, (_, dil) in enumerate(DILATED_GROUPS):
        o, lse = dilated_branch(q[:, :, g], k_sh[:, :, g], v_sh[:, :, g], dil, slopes)
        outs.append(o)
        lses.append(lse)
    wts = jax.nn.softmax(jnp.stack(lses, 0), axis=0)
    o = jnp.sum(wts[..., None] * jnp.stack(outs, 0), axis=0)
    return o.astype(h.dtype).reshape(bsz, seq, N_HEADS * HEAD_DIM) @ w_o


def setup_inputs(seed: int = 0) -> dict:
    key = jax.random.key(seed)
    ks = iter(jax.random.split(key, 32))

    def nrm(shape, scale):
        return jax.random.normal(next(ks), shape, dtype=jnp.float32) * scale

    def gain(shape):
        return 1.0 + nrm(shape, 0.02)

    D, F = D_MODEL, D_FF
    qkv_w = N_GROUPS * N_HEADS * HEAD_DIM
    return {
        "x": nrm((BATCH, SEQ, D), 1.0),
        "ffn1_norm": gain((DEPTH, D)),
        "ffn1_w_gate": nrm((DEPTH, D, F), D ** -0.5),
        "ffn1_w_up": nrm((DEPTH, D, F), D ** -0.5),
        "ffn1_w_down": nrm((DEPTH, F, D), F ** -0.5),
        "mix_norm": gain((DEPTH, D)),
        "ffn2_norm": gain((DEPTH, D)),
        "ffn2_w_gate": nrm((DEPTH, D, F), D ** -0.5),
        "ffn2_w_up": nrm((DEPTH, D, F), D ** -0.5),
        "ffn2_w_down": nrm((DEPTH, F, D), F ** -0.5),
        "gmlp_w_in": nrm((N_A_LAYERS, D, 2 * GMLP_D_GATE), D ** -0.5),
        "gmlp_v_norm": gain((N_A_LAYERS, GMLP_D_GATE)),
        "gmlp_w_s": nrm((N_A_LAYERS, GMLP_GROUPS, GMLP_CHUNK, GMLP_CHUNK), GMLP_CHUNK ** -0.5),
        "gmlp_b_s": 1.0 + nrm((N_A_LAYERS, GMLP_GROUPS, GMLP_CHUNK), 0.02),
        "gmlp_w_out": nrm((N_A_LAYERS, GMLP_D_GATE, D), GMLP_D_GATE ** -0.5),
        "kv_norm": gain((D,)),
        "w_kv": nrm((D, 2 * qkv_w), D ** -0.5),
        "k_norm": gain((N_GROUPS, HEAD_DIM)),
        "attn_w_q": nrm((N_B_LAYERS, D, qkv_w), D ** -0.5),
        "attn_q_norm": gain((N_B_LAYERS, N_GROUPS, HEAD_DIM)),
        "attn_w_o": nrm((N_B_LAYERS, N_HEADS * HEAD_DIM, D), (N_HEADS * HEAD_DIM) ** -0.5),
    }


def reference(x, ffn1_norm, ffn1_w_gate, ffn1_w_up, ffn1_w_down, mix_norm,
              ffn2_norm, ffn2_w_gate, ffn2_w_up, ffn2_w_down,
              gmlp_w_in, gmlp_v_norm, gmlp_w_s, gmlp_b_s, gmlp_w_out,
              kv_norm, w_kv, k_norm, attn_w_q, attn_q_norm, attn_w_o):
    bsz, seq, _ = x.shape
    slopes = jnp.exp2(-8.0 * jnp.arange(1, N_HEADS + 1, dtype=jnp.float32) / N_HEADS)
    k_sh = v_sh = None
    for l in range(DEPTH):
        x = x + 0.5 * swiglu(rms_norm(x, ffn1_norm[l]), ffn1_w_gate[l], ffn1_w_up[l], ffn1_w_down[l])
        h = rms_norm(x, mix_norm[l])
        if l < N_A_LAYERS:
            x = x + gmlp_mixer(h, gmlp_w_in[l], gmlp_v_norm[l], gmlp_w_s[l], gmlp_b_s[l], gmlp_w_out[l])
        else:
            j = l - N_A_LAYERS
            x = x + dilated_mixer(h, k_sh, v_sh, attn_w_q[j], attn_q_norm[j], attn_w_o[j], slopes)
        x = x + 0.5 * swiglu(rms_norm(x, ffn2_norm[l]), ffn2_w_gate[l], ffn2_w_up[l], ffn2_w_down[l])
        if l == N_A_LAYERS - 1:
            kv = (rms_norm(x, kv_norm) @ w_kv).reshape(bsz, seq, 2, N_GROUPS, N_HEADS, HEAD_DIM)
            k_sh = rms_norm(kv[:, :, 0], k_norm[:, None, :])
            v_sh = kv[:, :, 1]
    return x
```

```cpp
#include <hip/hip_runtime.h>
#include <cstdio>
#include <cstdint>
#ifndef PG8_WGM
#define PG8_WGM 8
#endif
namespace pg8 {
#define PG8_LAS __attribute__((address_space(3)))
typedef unsigned short bf16_t;
typedef short bf16x8 __attribute__((ext_vector_type(8)));
typedef float f32x4 __attribute__((ext_vector_type(4)));
typedef unsigned u32x4 __attribute__((ext_vector_type(4)));
constexpr int BM = 256, BK = 64, HALF = 128, HTB = HALF * BK * 2  , STAGE_BYTES = 8 * HTB, NXCD = 8, WGM = PG8_WGM;

__host__ __device__ __forceinline__ int lds_byte(int r, int c) { const int st = (r >> 4) * 2 + (c >> 5), rr = r & 15, cc = c & 31, ob = rr * 64 + cc * 2; return st * 1024 + (ob ^ (((ob >> 9) & 1) << 5)); }
__host__ __device__ __forceinline__ void stage_rc(int b, int& R, int& C) { const int st = b / 1024, sb = b % 1024, swz = sb ^ (((sb >> 9) & 1) << 5); R = (st >> 1) * 16 + swz / 64; C = (st & 1) * 32 + (swz % 64) / 2; }
__host__ __device__ __forceinline__ int perm32(int rho) { const int n = rho >> 4, i = rho & 15; return 8 * (i >> 2) + 4 * n + (i & 3); }

struct Unit { int pm, pn; };
struct Gemm { const bf16_t* A; const bf16_t* Bt; int M, N, K; int dshA, dshB; };
__host__ __device__ __forceinline__ int tile_row0(int tile, int dsh) { const int p0 = tile * BM, q = p0 & 4095; return (p0 & ~4095) + (q >> (12 - dsh)) + ((q & ((4096 >> dsh) - 1)) << dsh); }

struct StaticOrder {
    int nM, nN, nwg, G, c;
    __host__ __device__ void init(int M, int N, int G_, int c_) { nM = M / BM; nN = N / BM; nwg = nM * nN; G = G_; c = c_; }
    __host__ __device__ bool next(int i, Unit& u) const {
        const long L = (long)i * G + c; if (L >= nwg) return false;
        int wgid = (int)L; { const int q = nwg / NXCD, r = nwg % NXCD, xcd = wgid % NXCD, off = wgid / NXCD; wgid = (xcd < r ? xcd * (q + 1) : r * (q + 1) + (xcd - r) * q) + off; }
        const int nig = WGM * nN, gid = wgid / nig, fm = gid * WGM, gsz = (nM - fm) < WGM ? (nM - fm) : WGM;
        u.pm = fm + ((wgid % nig) % gsz); u.pn = (wgid % nig) / gsz; return true;
    }
    __device__ __forceinline__ void a_ready(const Unit&) const {}
    __device__ __forceinline__ void done(const Unit&) const {}
};


#define PG8_GAS __attribute__((address_space(1)))
typedef __bf16 bf16x2_t __attribute__((ext_vector_type(2)));
typedef float f32x2_t __attribute__((ext_vector_type(2)));
typedef unsigned u32x2 __attribute__((ext_vector_type(2)));
__device__ __forceinline__ unsigned pk2(float lo, float hi) { f32x2_t v = {lo, hi}; bf16x2_t b = __builtin_convertvector(v, bf16x2_t); return __builtin_bit_cast(unsigned, b); }
__device__ __forceinline__ float xsig(float x, float y) { return x * __builtin_amdgcn_rcpf(1.0f + __builtin_amdgcn_exp2f(-1.4426950408889634f * y)); }
__device__ __forceinline__ float silu_f(float x) { return xsig(x, x); }
__device__ __forceinline__ float gelu_tanh_f(float x) { return xsig(x, 1.5957691216057308f * x * (1.0f + 0.044715f * x * x)); }
constexpr int PRE_OFF = STAGE_BYTES, TBL_OFF = STAGE_BYTES + 8192;
__device__ __forceinline__ float xrow16_sum(float x) {
    const auto s = __builtin_amdgcn_permlane16_swap(__float_as_uint(x), __float_as_uint(x), false, false); x = __uint_as_float(s[0]) + __uint_as_float(s[1]);
    const auto t = __builtin_amdgcn_permlane32_swap(__float_as_uint(x), __float_as_uint(x), false, false); return __uint_as_float(t[0]) + __uint_as_float(t[1]); }
template <int CTRL> __device__ __forceinline__ float dpp_mov(float x) { return __builtin_bit_cast(float, __builtin_amdgcn_mov_dpp(__builtin_bit_cast(int, x), CTRL, 0xf, 0xf, true)); }
__device__ __forceinline__ float half_row_sum(float x) { x += dpp_mov<0xB1>(x); x += dpp_mov<0x4E>(x); x += dpp_mov<0x141>(x); return x; }
__device__ __forceinline__ void pre_dma(const float* ssq, int tile, PG8_LAS unsigned char* lds, int wid, int) {
    int lane; asm volatile("v_mbcnt_lo_u32_b32 %0, -1, 0\n\tv_mbcnt_hi_u32_b32 %0, -1, %0" : "=v"(lane));
    __builtin_amdgcn_global_load_lds((const unsigned*)(ssq + ((size_t)tile * BM + 32 * wid) * 8 + 4 * lane), (PG8_LAS unsigned*)(lds + PRE_OFF + wid * 1024), 16, 0, 0); }
__device__ __forceinline__ void pre_dma_s(const float* ssq, int tile, int dsh, PG8_LAS unsigned char* lds, int wid) {
    int lane; asm volatile("v_mbcnt_lo_u32_b32 %0, -1, 0\n\tv_mbcnt_hi_u32_b32 %0, -1, %0" : "=v"(lane));
    __builtin_amdgcn_global_load_lds((const unsigned*)(ssq + ((size_t)tile_row0(tile, dsh) + (size_t)((32 * wid + (lane >> 1)) << dsh)) * 8 + 4 * (lane & 1)), (PG8_LAS unsigned*)(lds + PRE_OFF + wid * 1024), 16, 0, 0); }
__device__ __forceinline__ float row_ssq(const PG8_LAS unsigned char* lds, int lrow, int fq) { const f32x2_t a = *(const PG8_LAS f32x2_t*)(lds + PRE_OFF + (lrow * 8 + 2 * fq) * 4);
    return xrow16_sum(a[0] + a[1]); }
__device__ __forceinline__ float col_ssq(const PG8_LAS unsigned char* lds, int lcol, int fr) { float s = *(const PG8_LAS float*)(lds + PRE_OFF + (lcol * 8 + (fr & 7)) * 4);
    return half_row_sum(s); }
__device__ __forceinline__ float rstd_of(float ssq) { return __builtin_amdgcn_rsqf(ssq * (1.0f / 2048.0f) + 1e-6f); }

#ifndef NT_HIDDEN
#define NT_HIDDEN 0
#endif
#ifndef SWIGLU_C0
#define SWIGLU_C0 1
#endif
struct EpiSwiGLU {
    static constexpr bool PERM = true, AFTER_DRAIN = false;
    PG8_GAS bf16_t* O; int ldc; const float* ssq;
    static constexpr bool HAS_PRE = true, ZEROES_ACC = true, C0_FIRST = (SWIGLU_C0 != 0), STRIDED = false;
    __device__ __forceinline__ void pre_issue(const Unit& u, PG8_LAS unsigned char* lds, int wid, int lane) const { pre_dma(ssq, u.pm, lds, wid, lane); }
    __device__ __forceinline__ void operator()(f32x4 (&acc)[2][2][4][2], const Unit& u, int wr, int wc, int fr, int fq, PG8_LAS unsigned char* lds) const {
        const int row0 = u.pm * BM + wr * 64 + fr, col0 = u.pn * HALF + wc * 32 + 8 * fq;
        float rs[2][4];
#pragma unroll
        for (int ai = 0; ai < 2; ++ai)
#pragma unroll
            for (int m = 0; m < 4; ++m) rs[ai][m] = rstd_of(row_ssq(lds, wr * 64 + fr + ai * HALF + m * 16, fq));
#pragma unroll
        for (int ai = 0; ai < 2; ++ai)
#pragma unroll
            for (int m = 0; m < 4; ++m) { PG8_GAS bf16_t* rowp = O + (size_t)(row0 + ai * HALF + m * 16) * ldc + col0;
                const float r = rs[ai][m], kr = -1.4426950408889634f * r, r2 = r * r;
                u32x4 w;
#pragma unroll
                for (int n = 0; n < 2; ++n)
#pragma unroll
                    for (int h = 0; h < 2; ++h) { const f32x2_t g2 = {acc[ai][0][m][n][2 * h], acc[ai][0][m][n][2 * h + 1]}, u2 = {acc[ai][1][m][n][2 * h], acc[ai][1][m][n][2 * h + 1]};
                        const f32x2_t t2 = g2 * kr; f32x2_t d2 = {__builtin_amdgcn_exp2f(t2[0]), __builtin_amdgcn_exp2f(t2[1])}; d2 = d2 + 1.0f;
                        const f32x2_t q2 = {__builtin_amdgcn_rcpf(d2[0]), __builtin_amdgcn_rcpf(d2[1])}; const f32x2_t o2 = ((g2 * u2) * q2) * r2;
                        w[2 * n + h] = pk2(o2[0], o2[1]); }
                if (NT_HIDDEN) __builtin_nontemporal_store(w, (PG8_GAS u32x4*)rowp); else *(PG8_GAS u32x4*)rowp = w;
                acc[ai][0][m][0] = acc[ai][0][m][1] = acc[ai][1][m][0] = acc[ai][1][m][1] = (f32x4){0.f, 0.f, 0.f, 0.f}; }
    }
};
struct EpiResid {
    static constexpr bool PERM = true, AFTER_DRAIN = false;
    PG8_GAS bf16_t* X16; int ldc; float scale; PG8_GAS float* out; PG8_GAS float* ssq;
    static constexpr bool HAS_PRE = false, ZEROES_ACC = false, C0_FIRST = false, STRIDED = false;
    __device__ __forceinline__ void operator()(const f32x4 (&acc)[2][2][4][2], const Unit& u, int wr, int wc, int fr, int fq, PG8_LAS unsigned char* lds) const {
        PG8_GAS bf16_t* X16 = this->X16; float scale = this->scale; PG8_GAS float* out = this->out; PG8_GAS float* ssq = this->ssq;
        asm volatile("" : "+s"(X16), "+s"(scale), "+s"(out), "+s"(ssq));
        const int row0 = u.pm * BM + wr * 64 + fr, col0 = u.pn * BM + wc * 32 + 8 * fq;
        PG8_LAS float* T = (PG8_LAS float*)(lds + TBL_OFF);
#pragma unroll
        for (int ai = 0; ai < 2; ++ai)
#pragma unroll
            for (int m = 0; m < 4; ++m) { const int row = row0 + ai * HALF + m * 16; PG8_GAS bf16_t* rowp = X16 + (size_t)row * ldc + col0;
                u32x4 xw[2];
#pragma unroll
                for (int bj = 0; bj < 2; ++bj) xw[bj] = *(const PG8_GAS u32x4*)(rowp + bj * HALF);
                float ss = 0.f;
#pragma unroll
                for (int bj = 0; bj < 2; ++bj) {
                    f32x4 a = (f32x4){__uint_as_float(xw[bj].x << 16), __uint_as_float(xw[bj].x & 0xffff0000u), __uint_as_float(xw[bj].y << 16), __uint_as_float(xw[bj].y & 0xffff0000u)};
                    f32x4 b = (f32x4){__uint_as_float(xw[bj].z << 16), __uint_as_float(xw[bj].z & 0xffff0000u), __uint_as_float(xw[bj].w << 16), __uint_as_float(xw[bj].w & 0xffff0000u)};
                    a = a + acc[ai][bj][m][0] * scale; b = b + acc[ai][bj][m][1] * scale;
                    if (out) { PG8_GAS float* op = out + (size_t)row * ldc + col0 + bj * HALF; *(PG8_GAS f32x4*)op = a; *(PG8_GAS f32x4*)(op + 4) = b; }
                    else { ss += ((a[0] * a[0] + a[1] * a[1]) + (a[2] * a[2] + a[3] * a[3])) + ((b[0] * b[0] + b[1] * b[1]) + (b[2] * b[2] + b[3] * b[3]));
                        u32x4 w; w.x = pk2(a[0], a[1]); w.y = pk2(a[2], a[3]); w.z = pk2(b[0], b[1]); w.w = pk2(b[2], b[3]);
                        *(PG8_GAS u32x4*)(rowp + bj * HALF) = w; } }
                if (!out) { { float t_;
                        asm volatile("v_mov_b32 %1, %0\n\ts_nop 1\n\tv_permlane16_swap_b32 %0, %1\n\tv_add_f32 %0, %0, %1\n\tv_mov_b32 %1, %0\n\ts_nop 1\n\tv_permlane32_swap_b32 %0, %1\n\tv_add_f32 %0, %0, %1" : "+v"(ss), "=&v"(t_)); }
                    if (fq == 0) T[(wr * 64 + fr + ai * HALF + m * 16) * 4 + wc] = ss; }
                asm volatile("" ::: "memory"); }
        if (!out) {
            asm volatile("s_waitcnt lgkmcnt(0)" ::: "memory"); __builtin_amdgcn_s_barrier(); asm volatile("" ::: "memory");
            const int t = (wr * 4 + wc) * 64 + fr + 16 * fq;
            if (t < BM) { const f32x4 p = *(const PG8_LAS f32x4*)(T + t * 4); ssq[(size_t)(u.pm * BM + t) * 8 + u.pn] = (p[0] + p[1]) + (p[2] + p[3]); }
        }
    }
};
struct EpiBf16Rt {
    static constexpr bool PERM = true, AFTER_DRAIN = false;
    PG8_GAS bf16_t* O; int ldc; int act; int mode; int nmode; const float* ssq; const PG8_GAS float* kgain; int dsh;
    static constexpr bool HAS_PRE = true, ZEROES_ACC = false, C0_FIRST = false, STRIDED = true;
    __device__ __forceinline__ void pre_issue(const Unit& u, PG8_LAS unsigned char* lds, int wid, int lane) const { if (nmode) pre_dma_s(ssq, nmode == 2 ? u.pn : u.pm, dsh, lds, wid); }
    __device__ __forceinline__ void operator()(const f32x4 (&acc)[2][2][4][2], const Unit& u, int wr, int wc, int fr, int fq, PG8_LAS unsigned char* lds) const {
        const int row0 = u.pm * BM + wr * 64 + fr, col0 = u.pn * BM + wc * 32 + 8 * fq;
        f32x4 cs[2][2];
#pragma unroll
        for (int bj = 0; bj < 2; ++bj)
#pragma unroll
            for (int n = 0; n < 2; ++n) { cs[bj][n] = (f32x4){1.f, 1.f, 1.f, 1.f};
                if (nmode == 2) { const int c = wc * 32 + 8 * fq + bj * HALF + 4 * n; cs[bj][n] = (f32x4){rstd_of(col_ssq(lds, c, fr)), rstd_of(col_ssq(lds, c + 1, fr)), rstd_of(col_ssq(lds, c + 2, fr)), rstd_of(col_ssq(lds, c + 3, fr))}; } }
        PG8_LAS float* T = (PG8_LAS float*)(lds + TBL_OFF);
        if (mode == 1) {
#pragma unroll
            for (int ai = 0; ai < 2; ++ai)
#pragma unroll
                for (int m = 0; m < 4; ++m)
#pragma unroll
                    for (int bj = 0; bj < 2; ++bj) { const f32x4 a = acc[ai][bj][m][0], b = acc[ai][bj][m][1];
                        float ss = ((a[0] * a[0] + a[1] * a[1]) + (a[2] * a[2] + a[3] * a[3])) + ((b[0] * b[0] + b[1] * b[1]) + (b[2] * b[2] + b[3] * b[3]));
                        ss = xrow16_sum(ss);
                        if (fq == 0) T[((wr * 64 + fr + ai * HALF + m * 16) * 2 + bj) * 4 + wc] = ss; }
            asm volatile("s_waitcnt lgkmcnt(0)" ::: "memory"); __builtin_amdgcn_s_barrier(); asm volatile("" ::: "memory");
        }
#pragma unroll
        for (int ai = 0; ai < 2; ++ai)
#pragma unroll
            for (int m = 0; m < 4; ++m) { const int row = row0 + ai * HALF + m * 16;
                const float r = (nmode == 1) ? rstd_of(row_ssq(lds, wr * 64 + fr + ai * HALF + m * 16, fq)) : 1.0f;
#pragma unroll
                for (int bj = 0; bj < 2; ++bj) { f32x4 v0 = acc[ai][bj][m][0] * cs[bj][0] * r, v1 = acc[ai][bj][m][1] * cs[bj][1] * r;
                    if (mode == 1) { const f32x4 p = *(const PG8_LAS f32x4*)(T + ((wr * 64 + fr + ai * HALF + m * 16) * 2 + bj) * 4);
                        const float kr = __builtin_amdgcn_rsqf(((p[0] + p[1]) + (p[2] + p[3])) * (r * r) * (1.0f / 128.0f) + 1e-6f);
                        const PG8_GAS float* gp = kgain + ((col0 + bj * HALF) & 127);
                        v0 = v0 * (*(const PG8_GAS f32x4*)gp) * kr; v1 = v1 * (*(const PG8_GAS f32x4*)(gp + 4)) * kr; }
                    const int col = col0 + bj * HALF;
                    size_t off;
                    if (mode == 0) off = (size_t)row * ldc + col;
                    else if (mode == 1) off = (((size_t)(col >> 7) * 512 + (row >> 5)) << 12) + ((col & 127) >> 4) * 512 + (row & 31) * 16 + (col & 15);
                    else off = (((size_t)(row >> 7) * 512 + (col >> 5)) << 12) + ((row & 127) >> 5) * 1024 + (row & 31) * 16;
                    if (act) {
#pragma unroll
                        for (int j = 0; j < 4; ++j) { v0[j] = gelu_tanh_f(v0[j]); v1[j] = gelu_tanh_f(v1[j]); } }
                    u32x4 w; w.x = pk2(v0[0], v0[1]); w.y = pk2(v0[2], v0[3]); w.z = pk2(v1[0], v1[1]); w.w = pk2(v1[2], v1[3]);
                    if (mode == 2) {
                        const int a = (col & 31) >> 3; PG8_GAS bf16_t* tb = O + off + (a >> 1) * 512 + 4 * (a & 1);
                        u32x2 lo2, hi2; lo2.x = w.x; lo2.y = w.y; hi2.x = w.z; hi2.y = w.w;
                        *(PG8_GAS u32x2*)tb = lo2; *(PG8_GAS u32x2*)(tb + 8) = hi2;
                    } else *(PG8_GAS u32x4*)(O + off) = w; } }
    }
};

template <class Epi, class Sched, bool ALIGN_EPI = false, bool SP2 = false>
__device__ __forceinline__ void gemm_phase(PG8_LAS unsigned char* lds, const Gemm g, const Sched& S, const Epi& E, const int tid_in) {
    const int tid = tid_in, wid = __builtin_amdgcn_readfirstlane(tid >> 6), lane = tid & 63, wr = wid >> 2, wc = wid & 3, fr = lane & 15, fq = lane >> 4;
    const int K = g.K, nt = K / BK;
    unsigned voffA[2], voffB[2];
#pragma unroll
    for (int i = 0; i < 2; ++i) { int R, C; stage_rc(tid * 16 + i * 8192, R, C); const int Rb = Epi::PERM ? ((R & ~31) + perm32(R & 31)) : R;
        voffA[i] = (unsigned)(R * (Epi::STRIDED ? K << g.dshA : K) + C) * 2u; voffB[i] = (unsigned)(Rb * (Epi::STRIDED ? K << g.dshB : K) + C) * 2u; }
    const size_t kstep = (size_t)(BK * 2);
    const size_t hstep = (size_t)HALF * K * 2;
    const size_t hstepA = Epi::STRIDED ? hstep << g.dshA : hstep, hstepB = Epi::STRIDED ? hstep << g.dshB : hstep;
    const size_t tstep = 2 * hstep;
#define PG8_ABASE(pm_) (Epi::STRIDED ? (size_t)tile_row0((pm_), g.dshA) * (size_t)(K * 2) : (size_t)(pm_) * tstep)
#define PG8_BBASE(pn_) (Epi::STRIDED ? (size_t)tile_row0((pn_), g.dshB) * (size_t)(K * 2) : (size_t)(pn_) * tstep)
    const unsigned ldsw = (unsigned)wid * 1024u;
    const int aoff = lds_byte(wr * 64 + fr, fq * 8), boff = lds_byte(wc * 32 + fr, fq * 8);
#define PG8_SA(b, h) (((b) * 2 + (h)) * HTB)
#define PG8_SB(b, h) ((4 + (b) * 2 + (h)) * HTB)
#define PG8_STAGE(bufoff, gbase, voff) do { _Pragma("unroll") for (int _i = 0; _i < 2; ++_i) \
        __builtin_amdgcn_global_load_lds((const unsigned*)((const char*)(gbase) + (voff)[_i]), (PG8_LAS unsigned*)(lds + (bufoff) + ldsw + _i * 8192), 16, 0, 0); } while (0)
#define PG8_LDA(dst, b, h) do { _Pragma("unroll") for (int m = 0; m < 4; ++m) _Pragma("unroll") for (int k = 0; k < 2; ++k) dst[m][k] = *(const PG8_LAS bf16x8*)(lds + PG8_SA(b, h) + aoff + m * 2048 + k * 1024); } while (0)
#define PG8_LDB(dst, b, h) do { _Pragma("unroll") for (int n = 0; n < 2; ++n) _Pragma("unroll") for (int k = 0; k < 2; ++k) dst[n][k] = *(const PG8_LAS bf16x8*)(lds + PG8_SB(b, h) + boff + n * 2048 + k * 1024); } while (0)
#define PG8_MMA(ai, bj, At, Bt) do { __builtin_amdgcn_s_setprio(1); _Pragma("unroll") for (int m = 0; m < 4; ++m) _Pragma("unroll") for (int n = 0; n < 2; ++n) _Pragma("unroll") for (int k = 0; k < 2; ++k) \
        acc[ai][bj][m][n] = __builtin_amdgcn_mfma_f32_16x16x32_bf16(Bt[n][k], At[m][k], acc[ai][bj][m][n], 0, 0, 0); __builtin_amdgcn_s_setprio(0); } while (0)
#ifndef MMA_KOUTER
#define MMA_KOUTER 0
#endif
#define PG8_WAIT_V(n) asm volatile("s_waitcnt vmcnt(" #n ")" ::: "memory")
#define PG8_WAIT_L(n) asm volatile("s_waitcnt lgkmcnt(" #n ")" ::: "memory")
#define PG8_BAR __builtin_amdgcn_s_barrier()
#define PG8_SCHED __builtin_amdgcn_sched_barrier(0)
#if MMA_KOUTER
#define PG8_MMAZ(ai, bj, At, Bt, Z) do { __builtin_amdgcn_s_setprio(1); \
        _Pragma("unroll") for (int m = 0; m < 4; ++m) _Pragma("unroll") for (int n = 0; n < 2; ++n) acc[ai][bj][m][n] = __builtin_amdgcn_mfma_f32_16x16x32_bf16(Bt[n][0], At[m][0], (Z) ? (f32x4){0.f, 0.f, 0.f, 0.f} : acc[ai][bj][m][n], 0, 0, 0); \
        _Pragma("unroll") for (int m = 0; m < 4; ++m) _Pragma("unroll") for (int n = 0; n < 2; ++n) acc[ai][bj][m][n] = __builtin_amdgcn_mfma_f32_16x16x32_bf16(Bt[n][1], At[m][1], acc[ai][bj][m][n], 0, 0, 0); \
        __builtin_amdgcn_s_setprio(0); } while (0)
#else
#define PG8_MMAZ(ai, bj, At, Bt, Z) do { __builtin_amdgcn_s_setprio(1); _Pragma("unroll") for (int m = 0; m < 4; ++m) _Pragma("unroll") for (int n = 0; n < 2; ++n) { \
        acc[ai][bj][m][n] = __builtin_amdgcn_mfma_f32_16x16x32_bf16(Bt[n][0], At[m][0], (Z) ? (f32x4){0.f, 0.f, 0.f, 0.f} : acc[ai][bj][m][n], 0, 0, 0); \
        acc[ai][bj][m][n] = __builtin_amdgcn_mfma_f32_16x16x32_bf16(Bt[n][1], At[m][1], acc[ai][bj][m][n], 0, 0, 0); } __builtin_amdgcn_s_setprio(0); } while (0)
#endif
#define PG8_TRIP(T_, LAST_, Z_) do { \
        const char* a1 = cA + (size_t)((T_) + 1) * kstep; \
        const char* a2 = (LAST_) ? nA : cA + (size_t)((T_) + 2) * kstep; const char* b2 = (LAST_) ? nB : cB + (size_t)((T_) + 2) * kstep; \
        const char* a3 = a2 + kstep; const char* b3 = b2 + kstep; \
        if ((LAST_) && has_next) S.a_ready(nxt); \
        PG8_LDB(B0, 0, 0); PG8_LDB(B1, 0, 1); PG8_SCHED; PG8_LDA(At, 0, 0); PG8_STAGE(PG8_SA(1, 1), a1 + hstepA, voffA); \
        PG8_WAIT_V(8); PG8_WAIT_L(0); PG8_BAR; PG8_MMAZ(0, 0, At, B0, Z_); PG8_MMAZ(0, 1, At, B1, Z_); PG8_BAR; PG8_SCHED; \
        PG8_LDA(At, 0, 1); PG8_STAGE(PG8_SB(0, 0), b2, voffB); PG8_STAGE(PG8_SB(0, 1), b2 + hstepB, voffB); PG8_STAGE(PG8_SA(0, 0), a2, voffA); \
        PG8_WAIT_V(8); PG8_WAIT_L(0); PG8_BAR; PG8_MMAZ(1, 0, At, B0, Z_); PG8_MMAZ(1, 1, At, B1, Z_); PG8_BAR; PG8_SCHED; \
        PG8_LDB(B0, 1, 0); PG8_LDB(B1, 1, 1); PG8_SCHED; PG8_LDA(At, 1, 0); PG8_STAGE(PG8_SA(0, 1), a2 + hstepA, voffA); \
        PG8_WAIT_V(8); PG8_WAIT_L(0); PG8_BAR; PG8_MMAZ(0, 0, At, B0, 0); PG8_MMAZ(0, 1, At, B1, 0); PG8_BAR; PG8_SCHED; \
        PG8_LDA(At, 1, 1); PG8_STAGE(PG8_SB(1, 0), b3, voffB); PG8_STAGE(PG8_SB(1, 1), b3 + hstepB, voffB); PG8_STAGE(PG8_SA(1, 0), a3, voffA); \
        PG8_WAIT_V(8); PG8_WAIT_L(0); PG8_BAR; PG8_MMAZ(1, 0, At, B0, 0); PG8_MMAZ(1, 1, At, B1, 0); PG8_BAR; PG8_SCHED; } while (0)
    Unit cur, nxt; int ui = 0;
    if (!S.next(0, cur)) return;
    f32x4 acc[2][2][4][2];
#pragma unroll
    for (int a = 0; a < 2; ++a)
#pragma unroll
        for (int b = 0; b < 2; ++b)
#pragma unroll
            for (int m = 0; m < 4; ++m)
#pragma unroll
                for (int n = 0; n < 2; ++n) acc[a][b][m][n] = (f32x4){0.f, 0.f, 0.f, 0.f};
    bf16x8 At[4][2], B0[2][2], B1[2][2];
    const char* cA = (const char*)g.A + PG8_ABASE(cur.pm); const char* cB = (const char*)g.Bt + PG8_BBASE(cur.pn);
    S.a_ready(cur);
    if constexpr (Epi::HAS_PRE) E.pre_issue(cur, lds, wid, lane);
    if constexpr (SP2) {
        PG8_STAGE(PG8_SB(0, 0), cB, voffB); PG8_STAGE(PG8_SB(0, 1), cB + hstepB, voffB); PG8_STAGE(PG8_SA(0, 0), cA, voffA); PG8_STAGE(PG8_SA(0, 1), cA + hstepA, voffA);
        if (wr == 1) PG8_BAR;
        PG8_WAIT_V(2); PG8_BAR;
        PG8_STAGE(PG8_SB(1, 0), cB + kstep, voffB); PG8_STAGE(PG8_SA(1, 0), cA + kstep, voffA); PG8_STAGE(PG8_SB(1, 1), cB + hstepB + kstep, voffB);
        PG8_WAIT_V(6); PG8_BAR;
    } else {
        PG8_STAGE(PG8_SB(0, 0), cB, voffB); PG8_STAGE(PG8_SA(0, 0), cA, voffA); PG8_STAGE(PG8_SB(0, 1), cB + hstepB, voffB); PG8_STAGE(PG8_SA(0, 1), cA + hstepA, voffA);
        if (wr == 1) PG8_BAR;
        PG8_WAIT_V(4); PG8_BAR;
        PG8_STAGE(PG8_SB(1, 0), cB + kstep, voffB); PG8_STAGE(PG8_SA(1, 0), cA + kstep, voffA); PG8_STAGE(PG8_SB(1, 1), cB + hstepB + kstep, voffB);
        PG8_WAIT_V(6); PG8_BAR;
    }
    for (;;) {
        const bool has_next = S.next(ui + 1, nxt);
        const char* nA = has_next ? (const char*)g.A + PG8_ABASE(nxt.pm) : cA; const char* nB = has_next ? (const char*)g.Bt + PG8_BBASE(nxt.pn) : cB;
        static_assert(SP2, "this copy of the body keeps only the two-MFMA-blocks-per-barrier-pair form");
        if constexpr (Epi::C0_FIRST) { PG8_TRIP(0, false, 1);
            for (int t = 2; t < nt; t += 2) { const bool last = (t == nt - 2); if constexpr (Epi::HAS_PRE && !ALIGN_EPI) { if (t == 2 && ui > 0) E.pre_issue(cur, lds, wid, lane); } PG8_TRIP(t, last, 0); } }
        else { for (int t = 0; t < nt; t += 2) { const bool last = (t == nt - 2); if constexpr (Epi::HAS_PRE && !ALIGN_EPI) { if (t == 2 && ui > 0) E.pre_issue(cur, lds, wid, lane); } PG8_TRIP(t, last, 0); } }
        if constexpr (ALIGN_EPI) { if (wr == 0) PG8_BAR; }
        if constexpr (!Epi::AFTER_DRAIN) { int lane_e; asm volatile("v_mbcnt_lo_u32_b32 %0, -1, 0\n\tv_mbcnt_hi_u32_b32 %0, -1, %0" : "=v"(lane_e));
            E(acc, cur, wr, wc, lane_e & 15, lane_e >> 4, lds); S.done(cur); }
        if (!has_next) break;
        if constexpr (!Epi::C0_FIRST && !Epi::ZEROES_ACC)
#pragma unroll
        for (int a = 0; a < 2; ++a)
#pragma unroll
            for (int b = 0; b < 2; ++b)
#pragma unroll
                for (int m = 0; m < 4; ++m)
#pragma unroll
                    for (int n = 0; n < 2; ++n) acc[a][b][m][n] = (f32x4){0.f, 0.f, 0.f, 0.f};
        cur = nxt; cA = nA; cB = nB; ++ui;
        if constexpr (Epi::HAS_PRE && ALIGN_EPI) {
            PG8_BAR; E.pre_issue(cur, lds, wid, lane); }
        if constexpr (ALIGN_EPI) { if (wr == 1) PG8_BAR; }
    }
    PG8_WAIT_V(0);
    if constexpr (!ALIGN_EPI) { if (wr == 0) PG8_BAR; }
    PG8_BAR;
    if constexpr (Epi::AFTER_DRAIN) { E.fused(acc, cur, wr, wc, fr, fq, lds, wid, lane); S.done(cur); }
#undef PG8_ABASE
#undef PG8_BBASE
#undef PG8_SA
#undef PG8_SB
#undef PG8_STAGE
#undef PG8_LDA
#undef PG8_LDB
#undef PG8_MMA
#undef PG8_MMAZ
#undef PG8_TRIP
#undef PG8_WAIT_V
#undef PG8_WAIT_L
#undef PG8_BAR
#undef PG8_SCHED
}
}

#ifndef MK_PER_PHASE
#define MK_PER_PHASE 0
#endif
constexpr int NWAVES = 8;

constexpr int BATCH = 4, SEQ = 4096, DM = 2048, DFF = 5632, NH = 16, HD = 128, NGRP = 3;
constexpr int MTOK = BATCH * SEQ;
constexpr int QW = NGRP * NH * HD;
constexpr float EPS = 1e-6f;
constexpr float LOG2E = 1.4426950408889634f;
constexpr int NSTEPS = 13;
constexpr int NPHASES = 30;

constexpr size_t MiB = 1u << 20;
constexpr size_t SZ_GU = (size_t)2 * DFF * DM * 2, SZ_D = (size_t)DM * DFF * 2;
constexpr size_t WS_CTL = 0, CTL_ZERO_BYTES = 1 * MiB;
constexpr size_t WS_WGU_LO = 1 * MiB;
constexpr size_t WS_WD_LO = WS_WGU_LO + 4 * SZ_GU;
constexpr size_t WS_WIN = WS_WD_LO + 4 * SZ_D;
constexpr size_t WS_WOUT = WS_WIN + 2 * (size_t)4096 * DM * 2;
constexpr size_t WS_WGU_HI = WS_WOUT + 2 * (size_t)DM * DM * 2;
constexpr size_t WS_WD_HI = WS_WGU_HI + 4 * SZ_GU;
constexpr size_t WS_WKV = WS_WD_HI + 4 * SZ_D;
constexpr size_t WS_WQ = WS_WKV + (size_t)2 * QW * DM * 2;
constexpr size_t WS_WO = WS_WQ + 2 * (size_t)QW * DM * 2;
constexpr size_t WS_WS = WS_WO + 2 * (size_t)DM * DM * 2;
constexpr size_t WS_SSQ = WS_WS + 1 * MiB;
constexpr size_t WS_HN = WS_SSQ + 2 * MiB;
constexpr size_t WS_SCR = WS_HN + (size_t)MTOK * DM * 2;
constexpr size_t WS_KB = WS_SCR + 192 * MiB;
constexpr size_t WS_VT = WS_KB + 192 * MiB;
constexpr size_t WS_END = WS_VT + 192 * MiB;
constexpr size_t WS_OG = WS_WGU_LO;
static_assert(WS_OG + (size_t)MTOK * DM * 2 <= WS_WGU_HI, "o must stay inside the weights that are dead by layer 2");
__host__ __device__ constexpr size_t ws_gu(int fi) { return fi < 4 ? WS_WGU_LO + (size_t)fi * SZ_GU : WS_WGU_HI + (size_t)(fi - 4) * SZ_GU; }
__host__ __device__ constexpr size_t ws_d(int fi) { return fi < 4 ? WS_WD_LO + (size_t)fi * SZ_D : WS_WD_HI + (size_t)(fi - 4) * SZ_D; }
static_assert(WS_END <= (size_t)1506 * MiB, "d_ws map exceeds the guaranteed workspace");

constexpr int RING_OFF = 0, RING_BYTES = 131072;
constexpr int LDS_BYTES = 155648;
constexpr int MISC_OFF = LDS_BYTES - 256;
constexpr int TR_SCR_BYTES = 64 * 65 * 4;
static_assert(NWAVES * TR_SCR_BYTES <= MISC_OFF, "LDS map");

#define GAS __attribute__((address_space(1)))
#define LAS __attribute__((address_space(3)))
#define DI __device__ __forceinline__
typedef unsigned short bf16;
typedef unsigned u32x4 __attribute__((ext_vector_type(4)));
typedef unsigned u32x2 __attribute__((ext_vector_type(2)));
typedef float f32x4 __attribute__((ext_vector_type(4)));
typedef float f32x16 __attribute__((ext_vector_type(16)));
typedef short bf16x8 __attribute__((ext_vector_type(8)));
typedef GAS unsigned gu32;
#define RLX_AGENT __ATOMIC_RELAXED, __HIP_MEMORY_SCOPE_AGENT
#define LDS_WAIT() asm volatile("s_waitcnt lgkmcnt(0)" ::: "memory")
#define VM_WAIT() asm volatile("s_waitcnt vmcnt(0)" ::: "memory")
#define LAUNDER_V(x) asm volatile("" : "+v"(x))
#define LAUNDER_S(x) asm volatile("" : "+s"(x))
using pg8::pk2;
DI float bf_lo(unsigned w) { return __uint_as_float(w << 16); }
DI float bf_hi(unsigned w) { return __uint_as_float(w & 0xffff0000u); }
template <int CTRL> DI float dppf(float x) { return __builtin_bit_cast(float, __builtin_amdgcn_mov_dpp(__builtin_bit_cast(int, x), CTRL, 0xf, 0xf, true)); }
DI float wave_sum(float v) {
    v += dppf<0xB1>(v); v += dppf<0x4E>(v); v += dppf<0x141>(v); v += dppf<0x140>(v);
    const auto s = __builtin_amdgcn_permlane16_swap(__float_as_uint(v), __float_as_uint(v), false, false); v = __uint_as_float(s[0]) + __uint_as_float(s[1]);
    const auto t = __builtin_amdgcn_permlane32_swap(__float_as_uint(v), __float_as_uint(v), false, false); return __uint_as_float(t[0]) + __uint_as_float(t[1]);
}
DI float wave_max(float v) {
    v = fmaxf(v, dppf<0xB1>(v)); v = fmaxf(v, dppf<0x4E>(v)); v = fmaxf(v, dppf<0x141>(v)); v = fmaxf(v, dppf<0x140>(v));
    const auto s = __builtin_amdgcn_permlane16_swap(__float_as_uint(v), __float_as_uint(v), false, false); v = fmaxf(__uint_as_float(s[0]), __uint_as_float(s[1]));
    const auto t = __builtin_amdgcn_permlane32_swap(__float_as_uint(v), __float_as_uint(v), false, false); return fmaxf(__uint_as_float(t[0]), __uint_as_float(t[1]));
}

#define XB_TMO      128
#define XB_XCNT(j)  (256  + 64 * (j))
#define XB_XSUB(j)  (1280 + 64 * (j))
#define XB_XGEN(j)  (2304 + 64 * (j))
#define XB_TOP      3328
#define XB_TOPGEN   3392
#define XCD_BAR_WORDS 3456
#define XB_SPIN_CAP (1u << 18)

__device__ __forceinline__ unsigned xb_ld(unsigned* p)              { return __hip_atomic_load(p, __ATOMIC_RELAXED, __HIP_MEMORY_SCOPE_AGENT); }
__device__ __forceinline__ unsigned xb_add(unsigned* p, unsigned v) { return __hip_atomic_fetch_add(p, v, __ATOMIC_RELAXED, __HIP_MEMORY_SCOPE_AGENT); }
__device__ __forceinline__ unsigned xb_xcc_id() { return (unsigned)__builtin_amdgcn_s_getreg((3 << 11) | 20) & 0xFu; }
#define XB_SPIN(cond, bar) do { unsigned _sp = 0; while (cond) { __builtin_amdgcn_s_sleep(1); \
    if ((++_sp & 255u) == 0u) { if (xb_ld(&(bar)[XB_TMO])) break; if (_sp > XB_SPIN_CAP) { atomicAdd(&(bar)[XB_TMO], 1u); break; } } } } while (0)

struct XcdBarrier {
    unsigned* bar; unsigned x;
    volatile LAS unsigned* st;
};

__device__ __forceinline__ XcdBarrier xcd_barrier_post(unsigned* bar, volatile LAS unsigned* st) {
    XcdBarrier b; b.bar = bar; b.x = xb_xcc_id(); b.st = st;
    if (threadIdx.x == 0) (void)xb_add(&bar[XB_XCNT(b.x)], 1u);
    return b;
}
__device__ __forceinline__ void xcd_barrier_complete(unsigned* bar, unsigned x, unsigned& nloc, unsigned& nx) {
    const unsigned G = gridDim.x * gridDim.y * gridDim.z;
    unsigned sum, cnt, mine, sp = 0u;
    for (;;) {
        sum = 0u; cnt = 0u; mine = 0u;
#pragma unroll
        for (unsigned j = 0; j < 16; ++j) { const unsigned c = xb_ld(&bar[XB_XCNT(j)]); sum += c; cnt += (c > 0u) ? 1u : 0u; mine = (j == x) ? c : mine; }
        if (sum == G) break;
        __builtin_amdgcn_s_sleep(1);
        if ((++sp & 255u) == 0u) { if (xb_ld(&bar[XB_TMO])) break; if (sp > XB_SPIN_CAP) { atomicAdd(&bar[XB_TMO], 1u); break; } }
    }
    nloc = mine > 0u ? mine : 1u; nx = cnt > 0u ? cnt : 1u;
}

__device__ __forceinline__ void xcd_barrier(const XcdBarrier& b) {
    asm volatile("s_waitcnt vmcnt(0)" ::: "memory");
    __syncthreads();
    if (threadIdx.x == 0) {
        unsigned* bar = b.bar;
        __builtin_amdgcn_s_waitcnt(0);
        unsigned nloc = b.st[0], nx = b.st[1];
        if (nloc == 0u) { xcd_barrier_complete(bar, b.x, nloc, nx); b.st[0] = nloc; b.st[1] = nx; }
        const unsigned old = xb_add(&bar[XB_XSUB(b.x)], 1u);
        const unsigned gen = old / nloc;
        if (old + 1u == (gen + 1u) * nloc) {
            __builtin_amdgcn_fence(__ATOMIC_RELEASE, "agent");
            asm volatile("s_waitcnt vmcnt(0)" ::: "memory");
            const unsigned og = xb_add(&bar[XB_TOP], 1u);
            const unsigned tg = og / nx;
            if (og + 1u == (tg + 1u) * nx) xb_add(&bar[XB_TOPGEN], 1u);
            else XB_SPIN(xb_ld(&bar[XB_TOPGEN]) == tg, bar);
            __builtin_amdgcn_fence(__ATOMIC_ACQUIRE, "agent");
            xb_add(&bar[XB_XGEN(b.x)], 1u);
            asm volatile("s_waitcnt vmcnt(0)" ::: "memory");
        } else {
            XB_SPIN(xb_ld(&bar[XB_XGEN(b.x)]) == gen, bar);
            __builtin_amdgcn_fence(__ATOMIC_ACQUIRE, "agent");
            asm volatile("s_waitcnt vmcnt(0)" ::: "memory");
        }
    }
    __syncthreads();
}


#ifndef TR_NT
#define TR_NT 1
#endif
DI void tr_item(const float* W, const float* gk, int K, int N, bf16* WT, int kind, LAS float* scr, int item, int lane) {
    const int nblk = N >> 6, kb = item / nblk, nb = item - kb * nblk, k0 = kb << 6, n0 = nb << 6;
    const int kr = lane >> 4, nq = lane & 15;
    const float* src = W + (size_t)(k0 + kr) * N + n0 + 4 * nq;
#pragma unroll
    for (int i = 0; i < 16; ++i) { const f32x4 v = TR_NT ? __builtin_nontemporal_load((const f32x4*)(src + (size_t)(4 * i) * N)) : *(const f32x4*)(src + (size_t)(4 * i) * N); const float g = gk ? gk[k0 + 4 * i + kr] : 1.0f;
        LAS float* d = scr + (4 * i + kr) * 65 + 4 * nq; d[0] = v.x * g; d[1] = v.y * g; d[2] = v.z * g; d[3] = v.w * g; }
    LDS_WAIT();
    const int c = lane & 7, nn = lane >> 3;
    const int drow0 = kind == 0 ? n0 : (256 * (n0 >> 7) + (n0 & 127) + (kind == 2 ? 128 : 0));
#pragma unroll
    for (int j = 0; j < 8; ++j) { const int n = nn + 8 * j; const LAS float* s = scr + (8 * c) * 65 + n;
        u32x4 o; o.x = pk2(s[0 * 65], s[1 * 65]); o.y = pk2(s[2 * 65], s[3 * 65]); o.z = pk2(s[4 * 65], s[5 * 65]); o.w = pk2(s[6 * 65], s[7 * 65]);
        *(u32x4*)(WT + (size_t)(drow0 + n) * K + k0 + 8 * c) = o; }
    LDS_WAIT();
}
DI void tr_matrix(const float* W, const float* gk, int K, int N, bf16* WT, int kind, LAS float* scr, int gw, int NGW, int lane, int& off) {
    const int nitems = (K >> 6) * (N >> 6);
    int first = gw - off; if (first < 0) first += NGW;
    for (int it = first; it < nitems; it += NGW) tr_item(W, gk, K, N, WT, kind, scr, it, lane);
    off = (off + nitems) % NGW;
}

DI void xin_phase(const GAS float* xin, GAS bf16* x16, GAS float* ssq, int gw, int NGW, int lane) {
    for (int m = gw; m < MTOK; m += NGW) {
        const GAS f32x4* xr = (const GAS f32x4*)(xin + (size_t)m * DM) + lane;
        f32x4 v[8]; float ss = 0.f;
#pragma unroll
        for (int j = 0; j < 8; ++j) { v[j] = xr[64 * j]; ss += (v[j].x * v[j].x + v[j].y * v[j].y) + (v[j].z * v[j].z + v[j].w * v[j].w); }
        ss = wave_sum(ss);
        if (lane < 8) ssq[(size_t)m * 8 + lane] = lane == 0 ? ss : 0.f;
        GAS u32x2* d0 = (GAS u32x2*)(x16 + (size_t)m * DM) + lane;
#pragma unroll
        for (int j = 0; j < 8; ++j) { u32x2 o; o.x = pk2(v[j].x, v[j].y); o.y = pk2(v[j].z, v[j].w); d0[64 * j] = o; }
    }
}
DI void spatial_phase(const GAS bf16* U, const GAS bf16* VTg, GAS bf16* GATED, const GAS bf16* wsb, const GAS float* vg, const GAS float* bs, LAS unsigned char* lds, int G, int tid, int wave, int lane) {
    LAS float* red = (LAS float*)lds; LAS float* rstd = (LAS float*)(lds + 16384);
    const int q32 = lane & 31, hh = lane >> 5;
    for (int unit = blockIdx.x; unit < 256; unit += G) {
        const int n = unit >> 1, hf = unit & 1; const size_t tok0 = (size_t)n * 128;
        {
            const int o = tid & 15, cl = tid >> 4; float a8[8] = {0.f, 0.f, 0.f, 0.f, 0.f, 0.f, 0.f, 0.f};
            const GAS bf16* p = VTg + (size_t)cl * MTOK + tok0 + 8 * o;
#pragma unroll 16
            for (int i = 0; i < 64; ++i) { const u32x4 w = *(const GAS u32x4*)(p + (size_t)(32 * i) * MTOK);
                float f; f = bf_lo(w.x); a8[0] += f * f; f = bf_hi(w.x); a8[1] += f * f; f = bf_lo(w.y); a8[2] += f * f; f = bf_hi(w.y); a8[3] += f * f;
                f = bf_lo(w.z); a8[4] += f * f; f = bf_hi(w.z); a8[5] += f * f; f = bf_lo(w.w); a8[6] += f * f; f = bf_hi(w.w); a8[7] += f * f; }
            __syncthreads();
#pragma unroll
            for (int e = 0; e < 8; ++e) red[cl * 128 + 8 * o + e] = a8[e];
            __syncthreads();
            if (tid < 128) { float s = 0.f;
#pragma unroll 8
                for (int i = 0; i < 32; ++i) s += red[i * 128 + tid];
                rstd[tid] = 1.0f / sqrtf(s * (1.0f / DM) + EPS); }
            __syncthreads();
        }
        const int ct = wave & 3, pt0 = (wave >> 2) * 2;
        const int ns = 2 * pt0 + 4;
        const int p0 = 32 * pt0 + q32, p1 = p0 + 32;
#pragma unroll 1
        for (int gi = 0; gi < 8; ++gi) {
            const int g = hf * 8 + gi;
            const GAS bf16* ap = VTg + (size_t)(g * 128 + 32 * ct + q32) * MTOK + tok0 + 8 * hh;
            const GAS bf16* bp0 = wsb + ((size_t)g * 128 + p0) * 128 + 8 * hh;
            const GAS bf16* bp1 = bp0 + 32 * 128;
            u32x4 af[8], b0[8], b1[8];
#pragma unroll
            for (int s = 0; s < 8; ++s) if (s < ns) { af[s] = *(const GAS u32x4*)(ap + 16 * s); b0[s] = *(const GAS u32x4*)(bp0 + 16 * s); b1[s] = *(const GAS u32x4*)(bp1 + 16 * s); }
            const float bb0 = bs[g * 128 + p0], bb1 = bs[g * 128 + p1];
            u32x2 uw0[4], uw1[4]; f32x4 gv[4];
#pragma unroll
            for (int rq = 0; rq < 4; ++rq) { const int ch = g * 128 + 32 * ct + 8 * rq + 4 * hh;
                gv[rq] = *(const GAS f32x4*)(vg + ch); uw0[rq] = *(const GAS u32x2*)(U + (tok0 + p0) * DM + ch); uw1[rq] = *(const GAS u32x2*)(U + (tok0 + p1) * DM + ch); }
            f32x16 acc0, acc1;
#pragma unroll
            for (int i = 0; i < 16; ++i) { acc0[i] = 0.f; acc1[i] = 0.f; }
#pragma unroll
            for (int s = 0; s < 8; ++s) if (s < ns) {
                const int qb = 16 * s + 8 * hh;
                const f32x4 r0 = *(const LAS f32x4*)(rstd + qb), r1 = *(const LAS f32x4*)(rstd + qb + 4);
                const float rs[8] = {r0.x, r0.y, r0.z, r0.w, r1.x, r1.y, r1.z, r1.w};
                {   const u32x4 w = b0[s];
                    float f[8] = {bf_lo(w.x), bf_hi(w.x), bf_lo(w.y), bf_hi(w.y), bf_lo(w.z), bf_hi(w.z), bf_lo(w.w), bf_hi(w.w)};
#pragma unroll
                    for (int e = 0; e < 8; ++e) f[e] = (qb + e <= p0) ? f[e] * rs[e] : 0.f;
                    u32x4 o; o.x = pk2(f[0], f[1]); o.y = pk2(f[2], f[3]); o.z = pk2(f[4], f[5]); o.w = pk2(f[6], f[7]);
                    acc0 = __builtin_amdgcn_mfma_f32_32x32x16_bf16(__builtin_bit_cast(bf16x8, af[s]), __builtin_bit_cast(bf16x8, o), acc0, 0, 0, 0); }
                {   const u32x4 w = b1[s];
                    float f[8] = {bf_lo(w.x), bf_hi(w.x), bf_lo(w.y), bf_hi(w.y), bf_lo(w.z), bf_hi(w.z), bf_lo(w.w), bf_hi(w.w)};
#pragma unroll
                    for (int e = 0; e < 8; ++e) f[e] = (qb + e <= p1) ? f[e] * rs[e] : 0.f;
                    u32x4 o; o.x = pk2(f[0], f[1]); o.y = pk2(f[2], f[3]); o.z = pk2(f[4], f[5]); o.w = pk2(f[6], f[7]);
                    acc1 = __builtin_amdgcn_mfma_f32_32x32x16_bf16(__builtin_bit_cast(bf16x8, af[s]), __builtin_bit_cast(bf16x8, o), acc1, 0, 0, 0); }
            }
#pragma unroll
            for (int rq = 0; rq < 4; ++rq) {
                const int ch = g * 128 + 32 * ct + 8 * rq + 4 * hh;
                {   u32x2 o; o.x = pk2(bf_lo(uw0[rq].x) * (acc0[4 * rq + 0] * gv[rq].x + bb0), bf_hi(uw0[rq].x) * (acc0[4 * rq + 1] * gv[rq].y + bb0));
                    o.y = pk2(bf_lo(uw0[rq].y) * (acc0[4 * rq + 2] * gv[rq].z + bb0), bf_hi(uw0[rq].y) * (acc0[4 * rq + 3] * gv[rq].w + bb0));
                    *(GAS u32x2*)(GATED + (tok0 + p0) * DM + ch) = o; }
                {   u32x2 o; o.x = pk2(bf_lo(uw1[rq].x) * (acc1[4 * rq + 0] * gv[rq].x + bb1), bf_hi(uw1[rq].x) * (acc1[4 * rq + 1] * gv[rq].y + bb1));
                    o.y = pk2(bf_lo(uw1[rq].y) * (acc1[4 * rq + 2] * gv[rq].z + bb1), bf_hi(uw1[rq].y) * (acc1[4 * rq + 3] * gv[rq].w + bb1));
                    *(GAS u32x2*)(GATED + (tok0 + p1) * DM + ch) = o; }
            }
        }
    }
    __syncthreads();
}

DI void attn_phase(const GAS bf16* Q, const GAS bf16* KB, const GAS bf16* VT, GAS bf16* O, const GAS float* qn, const GAS float* kn, LAS unsigned char* lds, int G, int wave, int lane) {
    float mq = 0.f, mk = 0.f;
    for (int i = lane; i < NGRP * HD; i += 64) { mq = fmaxf(mq, fabsf(qn[i])); mk = fmaxf(mk, fabsf(kn[i])); }
    mq = wave_max(mq); mk = wave_max(mk);
    const float cref = fminf(11.313708499f * mq * mk, 40.0f) * LOG2E;
    LAS float* Ls = (LAS float*)(lds + 131072);
    volatile LAS unsigned* FL = (volatile LAS unsigned*)(lds + 131072 + 4096);
    if (wave == 0 && lane < 48) FL[lane] = 0u;
    unsigned seq = 0u;
    __syncthreads();
    for (int task = blockIdx.x; task < 512; task += G) {
        const int wsel = task & 255, nrd = task >> 8, bh = (wsel & 7) * 8 + nrd * 4 + (wsel >> 6), B = (wsel >> 3) & 7, b = bh >> 4, h = bh & 15;
        ++seq;
#pragma unroll 1
        for (int j = 0; j < 6; ++j) {
        int lane_l = lane; LAUNDER_V(lane_l);
        const int q32 = lane_l & 31, hh = lane_l >> 5;
        const int gi = j >> 1, g = 2 - gi, w16 = 8 * (j & 1) + wave;
        const int dsh = 2 * g, dil = 1 << dsh, L = SEQ >> dsh;
        const int r = w16 >> (4 - dsh), il = 32 * (w16 & ((16 >> dsh) - 1));
        const int i0 = (512 >> dsh) * B + il;
        const int trow = r + dil * (il + q32);
        const size_t tokbase = (size_t)b * SEQ + r;
        const int colq = g * (NH * HD) + h * HD + 8 * hh;
        const int kt0 = (i0 >> 5) >= 4 ? 0 : 4 - (i0 >> 5);
        const int tile0 = ((b * SEQ + r * L) >> 5) + (i0 >> 5) - 4;
        const GAS bf16* kblk = KB + (((size_t)g * NH + h) * 512) * 4096 + q32 * 16 + 8 * hh;
        const GAS bf16* vblk = VT + (((size_t)g * NH + h) * 512) * 4096 + q32 * 16 + 8 * hh;
        u32x4 kb0[8], kb1[8], kb2[8];
        const int rot = (9 - ((i0 >> 5) % 5)) % 5;
#define KT(i) (((i) + rot) >= 5 ? ((i) + rot) - 5 : ((i) + rot))
#define ATT_LOADK(buf, kt) do { const GAS bf16* kp_ = kblk + (size_t)(tile0 + ((kt) > kt0 ? (kt) : kt0)) * 4096; _Pragma("unroll") for (int s_ = 0; s_ < 8; ++s_) buf[s_] = *(const GAS u32x4*)(kp_ + 512 * s_); } while (0)
        u32x4 w[8];
        {   const GAS bf16* qrow = Q + (tokbase + (size_t)dil * (i0 + q32)) * QW + colq;
#pragma unroll
            for (int s = 0; s < 8; ++s) w[s] = *(const GAS u32x4*)(qrow + 16 * s);
        }
        ATT_LOADK(kb0, KT(0)); ATT_LOADK(kb1, KT(1)); ATT_LOADK(kb2, KT(2));
        bf16x8 qf[8];
        {   float ss = 0.f;
#pragma unroll
            for (int s = 0; s < 8; ++s) {
                float f; f = bf_lo(w[s].x); ss += f * f; f = bf_hi(w[s].x); ss += f * f; f = bf_lo(w[s].y); ss += f * f; f = bf_hi(w[s].y); ss += f * f;
                f = bf_lo(w[s].z); ss += f * f; f = bf_hi(w[s].z); ss += f * f; f = bf_lo(w[s].w); ss += f * f; f = bf_hi(w[s].w); ss += f * f; }
            { const auto t_ = __builtin_amdgcn_permlane32_swap(__float_as_uint(ss), __float_as_uint(ss), false, false); ss = __uint_as_float(t_[0]) + __uint_as_float(t_[1]); }
            const float rs = (1.0f / sqrtf(ss * (1.0f / HD) + EPS)) * (0.08838834764831845f * LOG2E);
#pragma unroll
            for (int s = 0; s < 8; ++s) { const GAS float* gp = qn + g * HD + 16 * s + 8 * hh; const f32x4 g0 = *(const GAS f32x4*)gp, g1 = *(const GAS f32x4*)(gp + 4);
                u32x4 o; o.x = pk2(bf_lo(w[s].x) * rs * g0.x, bf_hi(w[s].x) * rs * g0.y); o.y = pk2(bf_lo(w[s].y) * rs * g0.z, bf_hi(w[s].y) * rs * g0.w);
                o.z = pk2(bf_lo(w[s].z) * rs * g1.x, bf_hi(w[s].z) * rs * g1.y); o.w = pk2(bf_lo(w[s].w) * rs * g1.z, bf_hi(w[s].w) * rs * g1.w);
                qf[s] = __builtin_bit_cast(bf16x8, o); }
        }
        const float sl2 = __builtin_amdgcn_exp2f(-0.5f * (float)(h + 1)) * (float)dil * LOG2E;
        float lsum = 0.f;
        u32x4 pk[5][2];
#define ATT_SCORE(buf, i) do { { f32x16 st_; const int kt_ = KT(i); \
            int dbase_ = q32 + 128 - 32 * kt_ - 4 * hh; LAUNDER_V(dbase_);        \
            float nb_ = -fmaf(sl2, (float)dbase_, cref); nb_ = (kt_ >= kt0) ? nb_ : -1e30f;        \
            _Pragma("unroll") for (int rg_ = 0; rg_ < 16; ++rg_) { const int c_ = (rg_ & 3) + 8 * (rg_ >> 2); const float v_ = fmaf((float)c_, sl2, nb_); \
                st_[rg_] = ((unsigned)(dbase_ - c_) <= 128u) ? v_ : -1e30f; }                    \
            _Pragma("unroll") for (int s_ = 0; s_ < 8; ++s_) st_ = __builtin_amdgcn_mfma_f32_32x32x16_bf16(__builtin_bit_cast(bf16x8, buf[s_]), qf[s_], st_, 0, 0, 0); \
            if ((i) + 3 < 5) ATT_LOADK(buf, KT((i) + 3)); \
            float p_[16]; \
            _Pragma("unroll") for (int rg_ = 0; rg_ < 16; ++rg_) { p_[rg_] = __builtin_amdgcn_exp2f(st_[rg_]); lsum += p_[rg_]; } \
            _Pragma("unroll") for (int s2_ = 0; s2_ < 2; ++s2_) { pk[i][s2_].x = pk2(p_[8 * s2_ + 0], p_[8 * s2_ + 1]); pk[i][s2_].y = pk2(p_[8 * s2_ + 2], p_[8 * s2_ + 3]); \
                pk[i][s2_].z = pk2(p_[8 * s2_ + 4], p_[8 * s2_ + 5]); pk[i][s2_].w = pk2(p_[8 * s2_ + 6], p_[8 * s2_ + 7]); } \
        } } while (0)
#define ATT_LOADV(buf, kt) do { const GAS bf16* vp_ = vblk + (size_t)(tile0 + ((kt) > kt0 ? (kt) : kt0)) * 4096; _Pragma("unroll") for (int i_ = 0; i_ < 8; ++i_) buf[i_] = *(const GAS u32x4*)(vp_ + 512 * i_); } while (0)
        ATT_SCORE(kb0, 0); ATT_SCORE(kb1, 1); ATT_SCORE(kb2, 2); ATT_LOADV(kb2, KT(0));
        ATT_SCORE(kb0, 3); ATT_LOADV(kb0, KT(1)); ATT_SCORE(kb1, 4); ATT_LOADV(kb1, KT(2));
        f32x16 ot[4];
#pragma unroll
        for (int dt = 0; dt < 4; ++dt)
#pragma unroll
            for (int i = 0; i < 16; ++i) ot[dt][i] = 0.f;
#define ATT_PV(buf, i) do { { _Pragma("unroll") for (int dt_ = 0; dt_ < 4; ++dt_) _Pragma("unroll") for (int s2_ = 0; s2_ < 2; ++s2_) \
            ot[dt_] = __builtin_amdgcn_mfma_f32_32x32x16_bf16(__builtin_bit_cast(bf16x8, buf[2 * dt_ + s2_]), __builtin_bit_cast(bf16x8, pk[i][s2_]), ot[dt_], 0, 0, 0); \
            if ((i) + 3 < 5) ATT_LOADV(buf, KT((i) + 3)); } } while (0)
        ATT_PV(kb2, 0); ATT_PV(kb0, 1); ATT_PV(kb1, 2); ATT_PV(kb2, 3); ATT_PV(kb0, 4);
#undef KT
#undef ATT_LOADK
#undef ATT_SCORE
#undef ATT_LOADV
#undef ATT_PV
        { const auto t_ = __builtin_amdgcn_permlane32_swap(__float_as_uint(lsum), __float_as_uint(lsum), false, false); lsum = __uint_as_float(t_[0]) + __uint_as_float(t_[1]); }
        if (gi > 0) {
#pragma unroll 1
            for (int k = 0; k < 4; ++k) { const int fi_ = gi == 1 ? (w16 >> 2) + 4 * k : 16 + 4 * k + (w16 >> 2); while (FL[fi_] < seq) __builtin_amdgcn_s_sleep(1); }
            asm volatile("" ::: "memory"); }
        else {
#pragma unroll 1
            for (int k = 0; k < 16; ++k) while (FL[32 + k] + 1u < seq) __builtin_amdgcn_s_sleep(1);
            asm volatile("" ::: "memory"); }
        const int hsh = (trow ^ (trow >> 2) ^ (trow >> 4)) & 15;
        LAS unsigned char* srow = lds + trow * 256;
        float rinv = 1.0f;
        if (gi < 2) { if (hh == 0) Ls[gi * 512 + trow] = lsum; }
        else rinv = 1.0f / (lsum + Ls[trow] + Ls[512 + trow]);
        GAS bf16* op = O + (tokbase + (size_t)dil * (i0 + q32)) * DM + h * HD + 8 * hh;
#pragma unroll
        for (int dt = 0; dt < 4; ++dt)
#pragma unroll
            for (int pr = 0; pr < 2; ++pr) { const int r0 = 8 * pr, r1 = 8 * pr + 4;
                const unsigned a0 = pk2(ot[dt][r0 + 0], ot[dt][r0 + 1]), a1 = pk2(ot[dt][r0 + 2], ot[dt][r0 + 3]), b0 = pk2(ot[dt][r1 + 0], ot[dt][r1 + 1]), b1 = pk2(ot[dt][r1 + 2], ot[dt][r1 + 3]);
                const auto s0 = __builtin_amdgcn_permlane32_swap(a0, b0, false, false); const auto s1 = __builtin_amdgcn_permlane32_swap(a1, b1, false, false);
                u32x4 o; o.x = s0[0]; o.y = s1[0]; o.z = s0[1]; o.w = s1[1];
                LAS u32x4* sp = (LAS u32x4*)(srow + (((4 * dt + 2 * pr + hh) ^ hsh) << 4));
                if (gi == 0) *sp = o;
                else { const u32x4 a = *sp;
                    const float f0 = bf_lo(a.x) + bf_lo(o.x), f1 = bf_hi(a.x) + bf_hi(o.x), f2 = bf_lo(a.y) + bf_lo(o.y), f3 = bf_hi(a.y) + bf_hi(o.y);
                    const float f4 = bf_lo(a.z) + bf_lo(o.z), f5 = bf_hi(a.z) + bf_hi(o.z), f6 = bf_lo(a.w) + bf_lo(o.w), f7 = bf_hi(a.w) + bf_hi(o.w);
                    u32x4 w; w.x = pk2(f0 * rinv, f1 * rinv); w.y = pk2(f2 * rinv, f3 * rinv); w.z = pk2(f4 * rinv, f5 * rinv); w.w = pk2(f6 * rinv, f7 * rinv);
                    if (gi == 1) *sp = w; else *(GAS u32x4*)(op + 32 * dt + 16 * pr) = w; } }
        asm volatile("s_waitcnt lgkmcnt(0)" ::: "memory"); if (lane_l == 0) FL[16 * gi + w16] = seq;
        }
    }
}

struct Args { const float* in[21]; float* out; unsigned char* ws; int ph_lo, ph_hi; };
typedef __attribute__((address_space(4))) Args KArgs;
__global__ void __launch_bounds__(NWAVES * 64, 2) yoco_fwd(Args args) {
    extern __shared__ __attribute__((aligned(16))) unsigned char lds_raw[];
    LAS unsigned char* lds = (LAS unsigned char*)lds_raw;
    volatile LAS unsigned* MISC = (volatile LAS unsigned*)(lds + MISC_OFF);
    const int tid0 = threadIdx.x;
    const int wave0 = __builtin_amdgcn_readfirstlane(tid0 >> 6);
    const int G = gridDim.x, NGW = G * NWAVES;
    if (tid0 < 64) MISC[tid0] = 0u;
    __syncthreads();
    XcdBarrier bar; bar.bar = (unsigned*)(args.ws + WS_CTL) + 1024; bar.x = 0; bar.st = nullptr;
    if (!MK_PER_PHASE) bar = xcd_barrier_post((unsigned*)(args.ws + WS_CTL) + 1024, MISC + 8);
    const int lo = args.ph_lo, hi = args.ph_hi;
    int pc = 0;
#define PH_ON (pc >= lo && pc < hi)
#define PH_END do { if (!MK_PER_PHASE && pc >= lo && pc + 1 < hi) { XcdBarrier b_ = bar; LAUNDER_S(b_.bar); xcd_barrier(b_); } ++pc; } while (0)
#define PH_VARS int tid; asm volatile("v_mbcnt_lo_u32_b32 %0, -1, 0\n\tv_mbcnt_hi_u32_b32 %0, -1, %0" : "=v"(tid)); tid += wave0 * 64; const int lane = tid & 63, wave = __builtin_amdgcn_readfirstlane(tid >> 6), gw = blockIdx.x * NWAVES + wave; \
    const KArgs* ap = (const KArgs*)__builtin_amdgcn_kernarg_segment_ptr(); LAUNDER_S(ap); unsigned char* ws = ap->ws; LAUNDER_S(ws); float* X = ap->out; LAUNDER_S(X); (void)lane; (void)gw; \
    bf16* X16 = (bf16*)(ws + WS_HN); bf16* SCR = (bf16*)(ws + WS_SCR); bf16* KB = (bf16*)(ws + WS_KB); bf16* VT = (bf16*)(ws + WS_VT); (void)X16; (void)SCR; (void)KB; (void)VT; (void)X

    if (PH_ON) {
        PH_VARS;
        LAS float* scr = (LAS float*)(lds + wave * TR_SCR_BYTES);
        {
        int off = 0;
        for (int fi = 0; fi < 8; ++fi) { const int l = fi >> 1, sec = fi & 1;
            const float* wg = ap->in[sec ? 7 : 2] + (size_t)l * DM * DFF; const float* wu = ap->in[sec ? 8 : 3] + (size_t)l * DM * DFF; const float* wd = ap->in[sec ? 9 : 4] + (size_t)l * DFF * DM;
            const float* gn = ap->in[sec ? 6 : 1] + (size_t)l * DM;
            bf16* gu = (bf16*)(ws + ws_gu(fi));
            tr_matrix(wg, gn, DM, DFF, gu, 1, scr, gw, NGW, lane, off);
            tr_matrix(wu, gn, DM, DFF, gu, 2, scr, gw, NGW, lane, off);
            tr_matrix(wd, nullptr, DFF, DM, (bf16*)(ws + ws_d(fi)), 0, scr, gw, NGW, lane, off); }
        for (int l = 0; l < 2; ++l) {
            tr_matrix(ap->in[10] + (size_t)l * DM * 4096, ap->in[5] + (size_t)l * DM, DM, 4096, (bf16*)(ws + WS_WIN) + (size_t)l * 4096 * DM, 0, scr, gw, NGW, lane, off);
            tr_matrix(ap->in[14] + (size_t)l * DM * DM, nullptr, DM, DM, (bf16*)(ws + WS_WOUT) + (size_t)l * DM * DM, 0, scr, gw, NGW, lane, off);
            tr_matrix(ap->in[18] + (size_t)l * DM * QW, ap->in[5] + (size_t)(2 + l) * DM, DM, QW, (bf16*)(ws + WS_WQ) + (size_t)l * QW * DM, 0, scr, gw, NGW, lane, off);
            tr_matrix(ap->in[20] + (size_t)l * DM * DM, nullptr, DM, DM, (bf16*)(ws + WS_WO) + (size_t)l * DM * DM, 0, scr, gw, NGW, lane, off); }
        tr_matrix(ap->in[16], ap->in[15], DM, 2 * QW, (bf16*)(ws + WS_WKV), 0, scr, gw, NGW, lane, off);
        }
        {   const float* s = ap->in[12]; bf16* d = (bf16*)(ws + WS_WS);
            for (int i = gw * 64 + lane; i < 2 * 16 * 128 * 128 / 4; i += NGW * 64) { const f32x4 v = ((const f32x4*)s)[i]; u32x2 o; o.x = pk2(v.x, v.y); o.y = pk2(v.z, v.w); ((u32x2*)d)[i] = o; } }
        xin_phase((const GAS float*)ap->in[0], (GAS bf16*)X16, (GAS float*)(ws + WS_SSQ), gw, NGW, lane);
        __syncthreads();
    }
    PH_END;

    for (int s = 0; s < NSTEPS; ++s) {
        const bool isKV = (s == 6); const int s2 = s > 6 ? s - 1 : s; const int l = s2 / 3, kind = isKV ? 3 : s2 % 3;
        const size_t scur_off = WS_SSQ, snext_off = WS_SSQ;
        size_t rA_off = WS_SCR, rB_off = 0; int rK = DM; float rscale = 1.0f;
        if (kind == 0 || kind == 2) {
            const int fi = 2 * l + (kind == 2 ? 1 : 0);
            if (PH_ON) {
                PH_VARS;
                pg8::Gemm g{X16, (const bf16*)(ws + ws_gu(fi)), MTOK, 2 * DFF, DM}; pg8::StaticOrder S; S.init(MTOK, 2 * DFF, G, (int)blockIdx.x);
                pg8::EpiSwiGLU E{(GAS bf16*)SCR, DFF, (const float*)(ws + scur_off)};
                pg8::gemm_phase<pg8::EpiSwiGLU, pg8::StaticOrder, true, true>(lds + RING_OFF, g, S, E, tid);
            }
            PH_END;
            rA_off = WS_SCR; rB_off = ws_d(fi); rK = DFF; rscale = 0.5f;
        } else {
            int njobs; if (kind == 3) njobs = 6; else if (l < 2) njobs = 2; else njobs = 1;
            if (PH_ON) {
                for (int jb = 0; jb < njobs; ++jb) {
                    PH_VARS;
                    bf16* UU = SCR; bf16* VTG = SCR + (size_t)MTOK * DM;
                    const bf16* A; const bf16* Bt; int Mg, Ng, ldc, act; bf16* O;
                    int mode = 0, nmode = 1;
                    int dA = 0, dB = 0;
                    if (kind == 3) {
                        const int gq = jb >= 3 ? jb - 3 : jb;
                        if (jb < 3) { A = X16; dA = 2 * gq; nmode = 1; Bt = (const bf16*)(ws + WS_WKV) + (size_t)(gq * DM) * DM; Mg = MTOK; Ng = DM; O = KB + (size_t)gq * DM * MTOK; ldc = 0; act = 0; mode = 1; }
                        else { A = (const bf16*)(ws + WS_WKV) + (size_t)(QW + gq * DM) * DM; Bt = X16; dB = 2 * gq; nmode = 2; Mg = DM; Ng = MTOK; O = VT + (size_t)gq * DM * MTOK; ldc = 0; act = 0; mode = 2; }
                    } else if (l < 2) {
                        const bf16* win = (const bf16*)(ws + WS_WIN) + (size_t)l * 4096 * DM;
                        if (jb == 0) { A = X16; Bt = win; Mg = MTOK; Ng = DM; O = UU; ldc = DM; act = 1; }
                        else { A = win + (size_t)DM * DM; Bt = X16; Mg = DM; Ng = MTOK; O = VTG; ldc = MTOK; act = 1; nmode = 2; }
                    } else { A = X16; Bt = (const bf16*)(ws + WS_WQ) + (size_t)(l - 2) * QW * DM; Mg = MTOK; Ng = QW; O = SCR; ldc = QW; act = 0; }
                    pg8::Gemm g{A, Bt, Mg, Ng, DM, dA, dB}; pg8::StaticOrder S; S.init(Mg, Ng, G, (int)blockIdx.x);
                    const float* kgn = ap->in[17]; LAUNDER_S(kgn);
                    pg8::EpiBf16Rt E{(GAS bf16*)O, ldc, act, mode, nmode, (const float*)(ws + scur_off), (const GAS float*)(kgn + (kind == 3 && jb < 3 ? jb : 0) * HD), dA + dB};
                    pg8::gemm_phase<pg8::EpiBf16Rt, pg8::StaticOrder, true, true>(lds + RING_OFF, g, S, E, tid);
                }
            }
            PH_END;
            if (kind == 3) {
            } else if (l < 2) {
                if (PH_ON) { PH_VARS; bf16* UU = SCR; bf16* VTG = SCR + (size_t)MTOK * DM; bf16* GATED = SCR + (size_t)2 * MTOK * DM;
                    const float* vg = ap->in[11] + (size_t)l * DM; LAUNDER_S(vg); const float* bsp = ap->in[13] + (size_t)l * 16 * 128; LAUNDER_S(bsp);
                    spatial_phase((const GAS bf16*)UU, (const GAS bf16*)VTG, (GAS bf16*)GATED, (const GAS bf16*)(ws + WS_WS) + (size_t)l * 16 * 128 * 128, (const GAS float*)vg, (const GAS float*)bsp, lds, G, tid, wave, lane); }
                PH_END;
                rA_off = WS_SCR + (size_t)2 * MTOK * DM * 2; rB_off = WS_WOUT + (size_t)l * DM * DM * 2; rK = DM; rscale = 1.0f;
            } else {
                if (PH_ON) { PH_VARS; const float* qn = ap->in[19] + (size_t)(l - 2) * NGRP * HD; LAUNDER_S(qn); const float* kn = ap->in[17]; LAUNDER_S(kn);
                    attn_phase((const GAS bf16*)SCR, (const GAS bf16*)KB, (const GAS bf16*)VT, (GAS bf16*)(ws + WS_OG), (const GAS float*)qn, (const GAS float*)kn, lds, G, wave, lane);
                    }
                PH_END;
                rA_off = WS_OG; rB_off = WS_WO + (size_t)(l - 2) * DM * DM * 2; rK = DM; rscale = 1.0f;
            }
        }
        if (kind != 3) {
            if (PH_ON) {
                PH_VARS;
                pg8::Gemm g{(const bf16*)(ws + rA_off), (const bf16*)(ws + rB_off), MTOK, DM, rK}; pg8::StaticOrder S; S.init(MTOK, DM, G, (int)blockIdx.x);
                pg8::EpiResid E{(GAS bf16*)X16, DM, rscale, (s + 1 < NSTEPS) ? (GAS float*)nullptr : (GAS float*)X, (GAS float*)(ws + snext_off)};
                pg8::gemm_phase<pg8::EpiResid, pg8::StaticOrder, true, true>(lds + RING_OFF, g, S, E, tid);
            }
            PH_END;
        }
    }
#undef PH_ON
#undef PH_END
#undef PH_VARS
}

extern "C" void kernel_launch(void* const* d_in, const int* in_sizes, int n_in, void* d_out, int out_size, void* d_ws, size_t ws_size, hipStream_t stream) {
    static int grid = 0;
    if (grid == 0) {
        if (n_in != 21 || in_sizes[0] != MTOK * DM || out_size != MTOK * DM || ws_size < WS_END) { fprintf(stderr, "kernel_launch: unexpected shapes (n_in %d, in0 %d, out %d, ws %zu < %zu)\n", n_in, n_in > 0 ? in_sizes[0] : -1, out_size, ws_size, (size_t)WS_END); grid = -1; return; }
        int dev = 0, cus = 0, per_cu = 0;
        if (hipGetDevice(&dev) != hipSuccess || hipDeviceGetAttribute(&cus, hipDeviceAttributeMultiprocessorCount, dev) != hipSuccess) { grid = -1; return; }
        if (hipFuncSetAttribute((const void*)yoco_fwd, hipFuncAttributeMaxDynamicSharedMemorySize, LDS_BYTES) != hipSuccess) { fprintf(stderr, "kernel_launch: hipFuncSetAttribute failed\n"); grid = -1; return; }
        if (hipOccupancyMaxActiveBlocksPerMultiprocessor(&per_cu, (const void*)yoco_fwd, NWAVES * 64, LDS_BYTES) != hipSuccess || per_cu < 1) fprintf(stderr, "kernel_launch: occupancy query reports %d\n", per_cu);
        (void)hipGetLastError();
        grid = cus;
    }
    if (grid < 0) return;
    (void)hipMemsetAsync((char*)d_ws + WS_CTL, 0, CTL_ZERO_BYTES, stream);
    Args a{};
    for (int i = 0; i < 21; ++i) a.in[i] = (const float*)d_in[i];
    a.out = (float*)d_out; a.ws = (unsigned char*)d_ws;
#if MK_PER_PHASE
    for (int p = 0; p < NPHASES; ++p) { a.ph_lo = p; a.ph_hi = p + 1; hipLaunchKernelGGL(yoco_fwd, dim3(grid), dim3(NWAVES * 64), LDS_BYTES, stream, a); }
#else
    a.ph_lo = 0; a.ph_hi = 1 << 30;
    hipLaunchKernelGGL(yoco_fwd, dim3(grid), dim3(NWAVES * 64), LDS_BYTES, stream, a);
#endif
}
```

```cpp
#include <hip/hip_runtime.h>
#include <cstdio>
#include <cstdint>
#define TR_NT 1
#ifndef PG8_WGM
#define PG8_WGM 8
#endif
namespace pg8 {
#define PG8_LAS __attribute__((address_space(3)))
typedef unsigned short bf16_t;
typedef short bf16x8 __attribute__((ext_vector_type(8)));
typedef float f32x4 __attribute__((ext_vector_type(4)));
typedef unsigned u32x4 __attribute__((ext_vector_type(4)));
constexpr int BM = 256, BK = 64, HALF = 128, HTB = HALF * BK * 2  , STAGE_BYTES = 8 * HTB, NXCD = 8, WGM = PG8_WGM;

__host__ __device__ __forceinline__ int lds_byte(int r, int c) { const int st = (r >> 4) * 2 + (c >> 5), rr = r & 15, cc = c & 31, ob = rr * 64 + cc * 2; return st * 1024 + (ob ^ (((ob >> 9) & 1) << 5)); }
__host__ __device__ __forceinline__ void stage_rc(int b, int& R, int& C) { const int st = b / 1024, sb = b % 1024, swz = sb ^ (((sb >> 9) & 1) << 5); R = (st >> 1) * 16 + swz / 64; C = (st & 1) * 32 + (swz % 64) / 2; }
__host__ __device__ __forceinline__ int perm32(int rho) { const int n = rho >> 4, i = rho & 15; return 8 * (i >> 2) + 4 * n + (i & 3); }

struct Unit { int pm, pn; };
struct Gemm { const bf16_t* A; const bf16_t* Bt; int M, N, K; int dshA, dshB; };
__host__ __device__ __forceinline__ int tile_row0(int tile, int dsh) { const int p0 = tile * BM, q = p0 & 4095; return (p0 & ~4095) + (q >> (12 - dsh)) + ((q & ((4096 >> dsh) - 1)) << dsh); }

struct StaticOrder {
    int nM, nN, nwg, G, c;
    __host__ __device__ void init(int M, int N, int G_, int c_) { nM = M / BM; nN = N / BM; nwg = nM * nN; G = G_; c = c_; }
    __host__ __device__ bool next(int i, Unit& u) const {
        const long L = (long)i * G + c; if (L >= nwg) return false;
        int wgid = (int)L; { const int q = nwg / NXCD, r = nwg % NXCD, xcd = wgid % NXCD, off = wgid / NXCD; wgid = (xcd < r ? xcd * (q + 1) : r * (q + 1) + (xcd - r) * q) + off; }
        const int nig = WGM * nN, gid = wgid / nig, fm = gid * WGM, gsz = (nM - fm) < WGM ? (nM - fm) : WGM;
        u.pm = fm + ((wgid % nig) % gsz); u.pn = (wgid % nig) / gsz; return true;
    }
    __device__ __forceinline__ void a_ready(const Unit&) const {}
    __device__ __forceinline__ void done(const Unit&) const {}
};


#define PG8_GAS __attribute__((address_space(1)))
typedef __bf16 bf16x2_t __attribute__((ext_vector_type(2)));
typedef float f32x2_t __attribute__((ext_vector_type(2)));
typedef unsigned u32x2 __attribute__((ext_vector_type(2)));
__device__ __forceinline__ unsigned pk2(float lo, float hi) { f32x2_t v = {lo, hi}; bf16x2_t b = __builtin_convertvector(v, bf16x2_t); return __builtin_bit_cast(unsigned, b); }
__device__ __forceinline__ float xsig(float x, float y) { return x * __builtin_amdgcn_rcpf(1.0f + __builtin_amdgcn_exp2f(-1.4426950408889634f * y)); }
__device__ __forceinline__ float silu_f(float x) { return xsig(x, x); }
__device__ __forceinline__ float gelu_tanh_f(float x) { return xsig(x, 1.5957691216057308f * x * (1.0f + 0.044715f * x * x)); }
constexpr int PRE_OFF = STAGE_BYTES, TBL_OFF = STAGE_BYTES + 8192;
__device__ __forceinline__ float xrow16_sum(float x) {
    const auto s = __builtin_amdgcn_permlane16_swap(__float_as_uint(x), __float_as_uint(x), false, false); x = __uint_as_float(s[0]) + __uint_as_float(s[1]);
    const auto t = __builtin_amdgcn_permlane32_swap(__float_as_uint(x), __float_as_uint(x), false, false); return __uint_as_float(t[0]) + __uint_as_float(t[1]); }
template <int CTRL> __device__ __forceinline__ float dpp_mov(float x) { return __builtin_bit_cast(float, __builtin_amdgcn_mov_dpp(__builtin_bit_cast(int, x), CTRL, 0xf, 0xf, true)); }
__device__ __forceinline__ float half_row_sum(float x) { x += dpp_mov<0xB1>(x); x += dpp_mov<0x4E>(x); x += dpp_mov<0x141>(x); return x; }
__device__ __forceinline__ void pre_dma(const float* ssq, int tile, PG8_LAS unsigned char* lds, int wid, int) {
    int lane; asm volatile("v_mbcnt_lo_u32_b32 %0, -1, 0\n\tv_mbcnt_hi_u32_b32 %0, -1, %0" : "=v"(lane));
    __builtin_amdgcn_global_load_lds((const unsigned*)(ssq + ((size_t)tile * BM + 32 * wid) * 8 + 4 * lane), (PG8_LAS unsigned*)(lds + PRE_OFF + wid * 1024), 16, 0, 0); }
__device__ __forceinline__ void pre_dma_s(const float* ssq, int tile, int dsh, PG8_LAS unsigned char* lds, int wid) {
    int lane; asm volatile("v_mbcnt_lo_u32_b32 %0, -1, 0\n\tv_mbcnt_hi_u32_b32 %0, -1, %0" : "=v"(lane));
    __builtin_amdgcn_global_load_lds((const unsigned*)(ssq + ((size_t)tile_row0(tile, dsh) + (size_t)((32 * wid + (lane >> 1)) << dsh)) * 8 + 4 * (lane & 1)), (PG8_LAS unsigned*)(lds + PRE_OFF + wid * 1024), 16, 0, 0); }
__device__ __forceinline__ float row_ssq(const PG8_LAS unsigned char* lds, int lrow, int fq) { const f32x2_t a = *(const PG8_LAS f32x2_t*)(lds + PRE_OFF + (lrow * 8 + 2 * fq) * 4);
    return xrow16_sum(a[0] + a[1]); }
__device__ __forceinline__ float col_ssq(const PG8_LAS unsigned char* lds, int lcol, int fr) { float s = *(const PG8_LAS float*)(lds + PRE_OFF + (lcol * 8 + (fr & 7)) * 4);
    return half_row_sum(s); }
__device__ __forceinline__ float rstd_of(float ssq) { return __builtin_amdgcn_rsqf(ssq * (1.0f / 2048.0f) + 1e-6f); }

#ifndef NT_HIDDEN
#define NT_HIDDEN 0
#endif
#ifndef SWIGLU_C0
#define SWIGLU_C0 1
#endif
struct EpiSwiGLU {
    static constexpr bool PERM = true, AFTER_DRAIN = false;
    PG8_GAS bf16_t* O; int ldc; const float* ssq;
    static constexpr bool HAS_PRE = true, ZEROES_ACC = true, C0_FIRST = (SWIGLU_C0 != 0), STRIDED = false;
    __device__ __forceinline__ void pre_issue(const Unit& u, PG8_LAS unsigned char* lds, int wid, int lane) const { pre_dma(ssq, u.pm, lds, wid, lane); }
    __device__ __forceinline__ void operator()(f32x4 (&acc)[2][2][4][2], const Unit& u, int wr, int wc, int fr, int fq, PG8_LAS unsigned char* lds) const {
        const int row0 = u.pm * BM + wr * 64 + fr, col0 = u.pn * HALF + wc * 32 + 8 * fq;
        float rs[2][4];
#pragma unroll
        for (int ai = 0; ai < 2; ++ai)
#pragma unroll
            for (int m = 0; m < 4; ++m) rs[ai][m] = rstd_of(row_ssq(lds, wr * 64 + fr + ai * HALF + m * 16, fq));
#pragma unroll
        for (int ai = 0; ai < 2; ++ai)
#pragma unroll
            for (int m = 0; m < 4; ++m) { PG8_GAS bf16_t* rowp = O + (size_t)(row0 + ai * HALF + m * 16) * ldc + col0;
                const float r = rs[ai][m], kr = -1.4426950408889634f * r, r2 = r * r;
                u32x4 w;
#pragma unroll
                for (int n = 0; n < 2; ++n)
#pragma unroll
                    for (int h = 0; h < 2; ++h) { const f32x2_t g2 = {acc[ai][0][m][n][2 * h], acc[ai][0][m][n][2 * h + 1]}, u2 = {acc[ai][1][m][n][2 * h], acc[ai][1][m][n][2 * h + 1]};
                        const f32x2_t t2 = g2 * kr; f32x2_t d2 = {__builtin_amdgcn_exp2f(t2[0]), __builtin_amdgcn_exp2f(t2[1])}; d2 = d2 + 1.0f;
                        const f32x2_t q2 = {__builtin_amdgcn_rcpf(d2[0]), __builtin_amdgcn_rcpf(d2[1])}; const f32x2_t o2 = ((g2 * u2) * q2) * r2;
                        w[2 * n + h] = pk2(o2[0], o2[1]); }
                if (NT_HIDDEN) __builtin_nontemporal_store(w, (PG8_GAS u32x4*)rowp); else *(PG8_GAS u32x4*)rowp = w;
                acc[ai][0][m][0] = acc[ai][0][m][1] = acc[ai][1][m][0] = acc[ai][1][m][1] = (f32x4){0.f, 0.f, 0.f, 0.f}; }
    }
};
struct EpiResid {
    static constexpr bool PERM = true, AFTER_DRAIN = false;
    PG8_GAS bf16_t* X16; int ldc; float scale; PG8_GAS float* out; PG8_GAS float* ssq;
    static constexpr bool HAS_PRE = false, ZEROES_ACC = false, C0_FIRST = false, STRIDED = false;
    __device__ __forceinline__ void operator()(const f32x4 (&acc)[2][2][4][2], const Unit& u, int wr, int wc, int fr, int fq, PG8_LAS unsigned char* lds) const {
        PG8_GAS bf16_t* X16 = this->X16; float scale = this->scale; PG8_GAS float* out = this->out; PG8_GAS float* ssq = this->ssq;
        asm volatile("" : "+s"(X16), "+s"(scale), "+s"(out), "+s"(ssq));
        const int row0 = u.pm * BM + wr * 64 + fr, col0 = u.pn * BM + wc * 32 + 8 * fq;
        PG8_LAS float* T = (PG8_LAS float*)(lds + TBL_OFF);
#pragma unroll
        for (int ai = 0; ai < 2; ++ai)
#pragma unroll
            for (int m = 0; m < 4; ++m) { const int row = row0 + ai * HALF + m * 16; PG8_GAS bf16_t* rowp = X16 + (size_t)row * ldc + col0;
                u32x4 xw[2];
#pragma unroll
                for (int bj = 0; bj < 2; ++bj) xw[bj] = *(const PG8_GAS u32x4*)(rowp + bj * HALF);
                float ss = 0.f;
#pragma unroll
                for (int bj = 0; bj < 2; ++bj) {
                    f32x4 a = (f32x4){__uint_as_float(xw[bj].x << 16), __uint_as_float(xw[bj].x & 0xffff0000u), __uint_as_float(xw[bj].y << 16), __uint_as_float(xw[bj].y & 0xffff0000u)};
                    f32x4 b = (f32x4){__uint_as_float(xw[bj].z << 16), __uint_as_float(xw[bj].z & 0xffff0000u), __uint_as_float(xw[bj].w << 16), __uint_as_float(xw[bj].w & 0xffff0000u)};
                    a = a + acc[ai][bj][m][0] * scale; b = b + acc[ai][bj][m][1] * scale;
                    if (out) { PG8_GAS float* op = out + (size_t)row * ldc + col0 + bj * HALF; *(PG8_GAS f32x4*)op = a; *(PG8_GAS f32x4*)(op + 4) = b; }
                    else { ss += ((a[0] * a[0] + a[1] * a[1]) + (a[2] * a[2] + a[3] * a[3])) + ((b[0] * b[0] + b[1] * b[1]) + (b[2] * b[2] + b[3] * b[3]));
                        u32x4 w; w.x = pk2(a[0], a[1]); w.y = pk2(a[2], a[3]); w.z = pk2(b[0], b[1]); w.w = pk2(b[2], b[3]);
                        *(PG8_GAS u32x4*)(rowp + bj * HALF) = w; } }
                if (!out) { { float t_;
                        asm volatile("v_mov_b32 %1, %0\n\ts_nop 1\n\tv_permlane16_swap_b32 %0, %1\n\tv_add_f32 %0, %0, %1\n\tv_mov_b32 %1, %0\n\ts_nop 1\n\tv_permlane32_swap_b32 %0, %1\n\tv_add_f32 %0, %0, %1" : "+v"(ss), "=&v"(t_)); }
                    if (fq == 0) T[(wr * 64 + fr + ai * HALF + m * 16) * 4 + wc] = ss; }
                asm volatile("" ::: "memory"); }
        if (!out) {
            asm volatile("s_waitcnt lgkmcnt(0)" ::: "memory"); __builtin_amdgcn_s_barrier(); asm volatile("" ::: "memory");
            const int t = (wr * 4 + wc) * 64 + fr + 16 * fq;
            if (t < BM) { const f32x4 p = *(const PG8_LAS f32x4*)(T + t * 4); ssq[(size_t)(u.pm * BM + t) * 8 + u.pn] = (p[0] + p[1]) + (p[2] + p[3]); }
        }
    }
};
struct EpiBf16Rt {
    static constexpr bool PERM = true, AFTER_DRAIN = false;
    PG8_GAS bf16_t* O; int ldc; int act; int mode; int nmode; const float* ssq; const PG8_GAS float* kgain; int dsh;
    static constexpr bool HAS_PRE = true, ZEROES_ACC = false, C0_FIRST = false, STRIDED = true;
    __device__ __forceinline__ void pre_issue(const Unit& u, PG8_LAS unsigned char* lds, int wid, int lane) const { if (nmode) pre_dma_s(ssq, nmode == 2 ? u.pn : u.pm, dsh, lds, wid); }
    __device__ __forceinline__ void operator()(const f32x4 (&acc)[2][2][4][2], const Unit& u, int wr, int wc, int fr, int fq, PG8_LAS unsigned char* lds) const {
        const int row0 = u.pm * BM + wr * 64 + fr, col0 = u.pn * BM + wc * 32 + 8 * fq;
        f32x4 cs[2][2];
#pragma unroll
        for (int bj = 0; bj < 2; ++bj)
#pragma unroll
            for (int n = 0; n < 2; ++n) { cs[bj][n] = (f32x4){1.f, 1.f, 1.f, 1.f};
                if (nmode == 2) { const int c = wc * 32 + 8 * fq + bj * HALF + 4 * n; cs[bj][n] = (f32x4){rstd_of(col_ssq(lds, c, fr)), rstd_of(col_ssq(lds, c + 1, fr)), rstd_of(col_ssq(lds, c + 2, fr)), rstd_of(col_ssq(lds, c + 3, fr))}; } }
        PG8_LAS float* T = (PG8_LAS float*)(lds + TBL_OFF);
        if (mode == 1) {
#pragma unroll
            for (int ai = 0; ai < 2; ++ai)
#pragma unroll
                for (int m = 0; m < 4; ++m)
#pragma unroll
                    for (int bj = 0; bj < 2; ++bj) { const f32x4 a = acc[ai][bj][m][0], b = acc[ai][bj][m][1];
                        float ss = ((a[0] * a[0] + a[1] * a[1]) + (a[2] * a[2] + a[3] * a[3])) + ((b[0] * b[0] + b[1] * b[1]) + (b[2] * b[2] + b[3] * b[3]));
                        ss = xrow16_sum(ss);
                        if (fq == 0) T[((wr * 64 + fr + ai * HALF + m * 16) * 2 + bj) * 4 + wc] = ss; }
            asm volatile("s_waitcnt lgkmcnt(0)" ::: "memory"); __builtin_amdgcn_s_barrier(); asm volatile("" ::: "memory");
        }
#pragma unroll
        for (int ai = 0; ai < 2; ++ai)
#pragma unroll
            for (int m = 0; m < 4; ++m) { const int row = row0 + ai * HALF + m * 16;
                const float r = (nmode == 1) ? rstd_of(row_ssq(lds, wr * 64 + fr + ai * HALF + m * 16, fq)) : 1.0f;
#pragma unroll
                for (int bj = 0; bj < 2; ++bj) { f32x4 v0 = acc[ai][bj][m][0] * cs[bj][0] * r, v1 = acc[ai][bj][m][1] * cs[bj][1] * r;
                    if (mode == 1) { const f32x4 p = *(const PG8_LAS f32x4*)(T + ((wr * 64 + fr + ai * HALF + m * 16) * 2 + bj) * 4);
                        const float kr = __builtin_amdgcn_rsqf(((p[0] + p[1]) + (p[2] + p[3])) * (r * r) * (1.0f / 128.0f) + 1e-6f);
                        const PG8_GAS float* gp = kgain + ((col0 + bj * HALF) & 127);
                        v0 = v0 * (*(const PG8_GAS f32x4*)gp) * kr; v1 = v1 * (*(const PG8_GAS f32x4*)(gp + 4)) * kr; }
                    const int col = col0 + bj * HALF;
                    size_t off;
                    if (mode == 0) off = (size_t)row * ldc + col;
                    else if (mode == 1) off = (((size_t)(col >> 7) * 512 + (row >> 5)) << 12) + ((col & 127) >> 4) * 512 + (row & 31) * 16 + (col & 15);
                    else off = (((size_t)(row >> 7) * 512 + (col >> 5)) << 12) + ((row & 127) >> 5) * 1024 + (row & 31) * 16;
                    if (act) {
#pragma unroll
                        for (int j = 0; j < 4; ++j) { v0[j] = gelu_tanh_f(v0[j]); v1[j] = gelu_tanh_f(v1[j]); } }
                    u32x4 w; w.x = pk2(v0[0], v0[1]); w.y = pk2(v0[2], v0[3]); w.z = pk2(v1[0], v1[1]); w.w = pk2(v1[2], v1[3]);
                    if (mode == 2) {
                        const int a = (col & 31) >> 3; PG8_GAS bf16_t* tb = O + off + (a >> 1) * 512 + 4 * (a & 1);
                        u32x2 lo2, hi2; lo2.x = w.x; lo2.y = w.y; hi2.x = w.z; hi2.y = w.w;
                        *(PG8_GAS u32x2*)tb = lo2; *(PG8_GAS u32x2*)(tb + 8) = hi2;
                    } else *(PG8_GAS u32x4*)(O + off) = w; } }
    }
};

template <class Epi, class Sched, bool ALIGN_EPI = false, bool SP2 = false>
__device__ __forceinline__ void gemm_phase(PG8_LAS unsigned char* lds, const Gemm g, const Sched& S, const Epi& E, const int tid_in) {
    const int tid = tid_in, wid = __builtin_amdgcn_readfirstlane(tid >> 6), lane = tid & 63, wr = wid >> 2, wc = wid & 3, fr = lane & 15, fq = lane >> 4;
    const int K = g.K, nt = K / BK;
    unsigned voffA[2], voffB[2];
#pragma unroll
    for (int i = 0; i < 2; ++i) { int R, C; stage_rc(tid * 16 + i * 8192, R, C); const int Rb = Epi::PERM ? ((R & ~31) + perm32(R & 31)) : R;
        voffA[i] = (unsigned)(R * (Epi::STRIDED ? K << g.dshA : K) + C) * 2u; voffB[i] = (unsigned)(Rb * (Epi::STRIDED ? K << g.dshB : K) + C) * 2u; }
    const size_t kstep = (size_t)(BK * 2);
    const size_t hstep = (size_t)HALF * K * 2;
    const size_t hstepA = Epi::STRIDED ? hstep << g.dshA : hstep, hstepB = Epi::STRIDED ? hstep << g.dshB : hstep;
    const size_t tstep = 2 * hstep;
#define PG8_ABASE(pm_) (Epi::STRIDED ? (size_t)tile_row0((pm_), g.dshA) * (size_t)(K * 2) : (size_t)(pm_) * tstep)
#define PG8_BBASE(pn_) (Epi::STRIDED ? (size_t)tile_row0((pn_), g.dshB) * (size_t)(K * 2) : (size_t)(pn_) * tstep)
    const unsigned ldsw = (unsigned)wid * 1024u;
    const int aoff = lds_byte(wr * 64 + fr, fq * 8), boff = lds_byte(wc * 32 + fr, fq * 8);
#define PG8_SA(b, h) (((b) * 2 + (h)) * HTB)
#define PG8_SB(b, h) ((4 + (b) * 2 + (h)) * HTB)
#define PG8_STAGE(bufoff, gbase, voff) do { _Pragma("unroll") for (int _i = 0; _i < 2; ++_i) \
        __builtin_amdgcn_global_load_lds((const unsigned*)((const char*)(gbase) + (voff)[_i]), (PG8_LAS unsigned*)(lds + (bufoff) + ldsw + _i * 8192), 16, 0, 0); } while (0)
#define PG8_LDA(dst, b, h) do { _Pragma("unroll") for (int m = 0; m < 4; ++m) _Pragma("unroll") for (int k = 0; k < 2; ++k) dst[m][k] = *(const PG8_LAS bf16x8*)(lds + PG8_SA(b, h) + aoff + m * 2048 + k * 1024); } while (0)
#define PG8_LDB(dst, b, h) do { _Pragma("unroll") for (int n = 0; n < 2; ++n) _Pragma("unroll") for (int k = 0; k < 2; ++k) dst[n][k] = *(const PG8_LAS bf16x8*)(lds + PG8_SB(b, h) + boff + n * 2048 + k * 1024); } while (0)
#define PG8_MMA(ai, bj, At, Bt) do { __builtin_amdgcn_s_setprio(1); _Pragma("unroll") for (int m = 0; m < 4; ++m) _Pragma("unroll") for (int n = 0; n < 2; ++n) _Pragma("unroll") for (int k = 0; k < 2; ++k) \
        acc[ai][bj][m][n] = __builtin_amdgcn_mfma_f32_16x16x32_bf16(Bt[n][k], At[m][k], acc[ai][bj][m][n], 0, 0, 0); __builtin_amdgcn_s_setprio(0); } while (0)
#define PG8_WAIT_V(n) asm volatile("s_waitcnt vmcnt(" #n ")" ::: "memory")
#define PG8_WAIT_L(n) asm volatile("s_waitcnt lgkmcnt(" #n ")" ::: "memory")
#define PG8_BAR __builtin_amdgcn_s_barrier()
#define PG8_SCHED __builtin_amdgcn_sched_barrier(0)
#define PG8_MMAZ(ai, bj, At, Bt, Z) do { __builtin_amdgcn_s_setprio(1); _Pragma("unroll") for (int m = 0; m < 4; ++m) _Pragma("unroll") for (int n = 0; n < 2; ++n) { \
        acc[ai][bj][m][n] = __builtin_amdgcn_mfma_f32_16x16x32_bf16(Bt[n][0], At[m][0], (Z) ? (f32x4){0.f, 0.f, 0.f, 0.f} : acc[ai][bj][m][n], 0, 0, 0); \
        acc[ai][bj][m][n] = __builtin_amdgcn_mfma_f32_16x16x32_bf16(Bt[n][1], At[m][1], acc[ai][bj][m][n], 0, 0, 0); } __builtin_amdgcn_s_setprio(0); } while (0)
#define PG8_TRIP(T_, LAST_, Z_) do { \
        const char* a1 = cA + (size_t)((T_) + 1) * kstep; \
        const char* a2 = (LAST_) ? nA : cA + (size_t)((T_) + 2) * kstep; const char* b2 = (LAST_) ? nB : cB + (size_t)((T_) + 2) * kstep; \
        const char* a3 = a2 + kstep; const char* b3 = b2 + kstep; \
        if ((LAST_) && has_next) S.a_ready(nxt); \
        PG8_LDB(B0, 0, 0); PG8_LDB(B1, 0, 1); PG8_SCHED; PG8_LDA(At, 0, 0); PG8_STAGE(PG8_SA(1, 1), a1 + hstepA, voffA); \
        PG8_WAIT_V(8); PG8_WAIT_L(0); PG8_BAR; PG8_MMAZ(0, 0, At, B0, Z_); PG8_MMAZ(0, 1, At, B1, Z_); PG8_BAR; PG8_SCHED; \
        PG8_LDA(At, 0, 1); PG8_STAGE(PG8_SB(0, 0), b2, voffB); PG8_STAGE(PG8_SB(0, 1), b2 + hstepB, voffB); PG8_STAGE(PG8_SA(0, 0), a2, voffA); \
        PG8_WAIT_V(8); PG8_WAIT_L(0); PG8_BAR; PG8_MMAZ(1, 0, At, B0, Z_); PG8_MMAZ(1, 1, At, B1, Z_); PG8_BAR; PG8_SCHED; \
        PG8_LDB(B0, 1, 0); PG8_LDB(B1, 1, 1); PG8_SCHED; PG8_LDA(At, 1, 0); PG8_STAGE(PG8_SA(0, 1), a2 + hstepA, voffA); \
        PG8_WAIT_V(8); PG8_WAIT_L(0); PG8_BAR; PG8_MMAZ(0, 0, At, B0, 0); PG8_MMAZ(0, 1, At, B1, 0); PG8_BAR; PG8_SCHED; \
        PG8_LDA(At, 1, 1); PG8_STAGE(PG8_SB(1, 0), b3, voffB); PG8_STAGE(PG8_SB(1, 1), b3 + hstepB, voffB); PG8_STAGE(PG8_SA(1, 0), a3, voffA); \
        PG8_WAIT_V(8); PG8_WAIT_L(0); PG8_BAR; PG8_MMAZ(1, 0, At, B0, 0); PG8_MMAZ(1, 1, At, B1, 0); PG8_BAR; PG8_SCHED; } while (0)
    Unit cur, nxt; int ui = 0;
    if (!S.next(0, cur)) return;
    f32x4 acc[2][2][4][2];
#pragma unroll
    for (int a = 0; a < 2; ++a)
#pragma unroll
        for (int b = 0; b < 2; ++b)
#pragma unroll
            for (int m = 0; m < 4; ++m)
#pragma unroll
                for (int n = 0; n < 2; ++n) acc[a][b][m][n] = (f32x4){0.f, 0.f, 0.f, 0.f};
    bf16x8 At[4][2], B0[2][2], B1[2][2];
    const char* cA = (const char*)g.A + PG8_ABASE(cur.pm); const char* cB = (const char*)g.Bt + PG8_BBASE(cur.pn);
    S.a_ready(cur);
    if constexpr (Epi::HAS_PRE) E.pre_issue(cur, lds, wid, lane);
    if constexpr (SP2) {
        PG8_STAGE(PG8_SB(0, 0), cB, voffB); PG8_STAGE(PG8_SB(0, 1), cB + hstepB, voffB); PG8_STAGE(PG8_SA(0, 0), cA, voffA); PG8_STAGE(PG8_SA(0, 1), cA + hstepA, voffA);
        if (wr == 1) PG8_BAR;
        PG8_WAIT_V(2); PG8_BAR;
        PG8_STAGE(PG8_SB(1, 0), cB + kstep, voffB); PG8_STAGE(PG8_SA(1, 0), cA + kstep, voffA); PG8_STAGE(PG8_SB(1, 1), cB + hstepB + kstep, voffB);
        PG8_WAIT_V(6); PG8_BAR;
    } else {
        PG8_STAGE(PG8_SB(0, 0), cB, voffB); PG8_STAGE(PG8_SA(0, 0), cA, voffA); PG8_STAGE(PG8_SB(0, 1), cB + hstepB, voffB); PG8_STAGE(PG8_SA(0, 1), cA + hstepA, voffA);
        if (wr == 1) PG8_BAR;
        PG8_WAIT_V(4); PG8_BAR;
        PG8_STAGE(PG8_SB(1, 0), cB + kstep, voffB); PG8_STAGE(PG8_SA(1, 0), cA + kstep, voffA); PG8_STAGE(PG8_SB(1, 1), cB + hstepB + kstep, voffB);
        PG8_WAIT_V(6); PG8_BAR;
    }
    for (;;) {
        const bool has_next = S.next(ui + 1, nxt);
        const char* nA = has_next ? (const char*)g.A + PG8_ABASE(nxt.pm) : cA; const char* nB = has_next ? (const char*)g.Bt + PG8_BBASE(nxt.pn) : cB;
        static_assert(SP2, "this copy of the body keeps only the two-MFMA-blocks-per-barrier-pair form");
        if constexpr (Epi::C0_FIRST) { PG8_TRIP(0, false, 1);
            for (int t = 2; t < nt; t += 2) { const bool last = (t == nt - 2); PG8_TRIP(t, last, 0); } }
        else { for (int t = 0; t < nt; t += 2) { const bool last = (t == nt - 2); PG8_TRIP(t, last, 0); } }
        if constexpr (ALIGN_EPI) { if (wr == 0) PG8_BAR; }
        if constexpr (!Epi::AFTER_DRAIN) { int lane_e; asm volatile("v_mbcnt_lo_u32_b32 %0, -1, 0\n\tv_mbcnt_hi_u32_b32 %0, -1, %0" : "=v"(lane_e));
            E(acc, cur, wr, wc, lane_e & 15, lane_e >> 4, lds); S.done(cur); }
        if (!has_next) break;
        if constexpr (!Epi::C0_FIRST && !Epi::ZEROES_ACC)
#pragma unroll
        for (int a = 0; a < 2; ++a)
#pragma unroll
            for (int b = 0; b < 2; ++b)
#pragma unroll
                for (int m = 0; m < 4; ++m)
#pragma unroll
                    for (int n = 0; n < 2; ++n) acc[a][b][m][n] = (f32x4){0.f, 0.f, 0.f, 0.f};
        cur = nxt; cA = nA; cB = nB; ++ui;
        if constexpr (Epi::HAS_PRE) { static_assert(ALIGN_EPI, "the statistics hand-over assumes both halves run their epilogues together");
            PG8_BAR; E.pre_issue(cur, lds, wid, lane); }
        if constexpr (ALIGN_EPI) { if (wr == 1) PG8_BAR; }
    }
    PG8_WAIT_V(0);
    if constexpr (!ALIGN_EPI) { if (wr == 0) PG8_BAR; }
    PG8_BAR;
    if constexpr (Epi::AFTER_DRAIN) { E.fused(acc, cur, wr, wc, fr, fq, lds, wid, lane); S.done(cur); }
#undef PG8_ABASE
#undef PG8_BBASE
#undef PG8_SA
#undef PG8_SB
#undef PG8_STAGE
#undef PG8_LDA
#undef PG8_LDB
#undef PG8_MMA
#undef PG8_MMAZ
#undef PG8_TRIP
#undef PG8_WAIT_V
#undef PG8_WAIT_L
#undef PG8_BAR
#undef PG8_SCHED
}
}

#ifndef MK_PER_PHASE
#define MK_PER_PHASE 0
#endif
constexpr int NWAVES = 8;

constexpr int BATCH = 4, SEQ = 4096, DM = 2048, DFF = 5632, NH = 16, HD = 128, NGRP = 3;
constexpr int MTOK = BATCH * SEQ;
constexpr int QW = NGRP * NH * HD;
constexpr float EPS = 1e-6f;
constexpr float LOG2E = 1.4426950408889634f;
constexpr int NSTEPS = 13;
constexpr int NPHASES = 30;

constexpr size_t MiB = 1u << 20;
constexpr size_t SZ_GU = (size_t)2 * DFF * DM * 2, SZ_D = (size_t)DM * DFF * 2;
constexpr size_t WS_CTL = 0, CTL_ZERO_BYTES = 1 * MiB;
constexpr size_t WS_WGU_LO = 1 * MiB;
constexpr size_t WS_WD_LO = WS_WGU_LO + 4 * SZ_GU;
constexpr size_t WS_WIN = WS_WD_LO + 4 * SZ_D;
constexpr size_t WS_WOUT = WS_WIN + 2 * (size_t)4096 * DM * 2;
constexpr size_t WS_WGU_HI = WS_WOUT + 2 * (size_t)DM * DM * 2;
constexpr size_t WS_WD_HI = WS_WGU_HI + 4 * SZ_GU;
constexpr size_t WS_WKV = WS_WD_HI + 4 * SZ_D;
constexpr size_t WS_WQ = WS_WKV + (size_t)2 * QW * DM * 2;
constexpr size_t WS_WO = WS_WQ + 2 * (size_t)QW * DM * 2;
constexpr size_t WS_WS = WS_WO + 2 * (size_t)DM * DM * 2;
constexpr size_t WS_SSQ = WS_WS + 1 * MiB;
constexpr size_t WS_HN = WS_SSQ + 2 * MiB;
constexpr size_t WS_SCR = WS_HN + (size_t)MTOK * DM * 2;
constexpr size_t WS_KB = WS_SCR + 192 * MiB;
constexpr size_t WS_VT = WS_KB + 192 * MiB;
constexpr size_t WS_END = WS_VT + 192 * MiB;
constexpr size_t WS_OG = WS_WGU_LO;
constexpr size_t WS_LG = WS_OG + 192 * MiB;
static_assert(WS_LG + 3 * MiB <= WS_WGU_HI, "OG/LG must stay inside the weights that are dead by layer 2");
__host__ __device__ constexpr size_t ws_gu(int fi) { return fi < 4 ? WS_WGU_LO + (size_t)fi * SZ_GU : WS_WGU_HI + (size_t)(fi - 4) * SZ_GU; }
__host__ __device__ constexpr size_t ws_d(int fi) { return fi < 4 ? WS_WD_LO + (size_t)fi * SZ_D : WS_WD_HI + (size_t)(fi - 4) * SZ_D; }
static_assert(WS_END <= (size_t)1506 * MiB, "d_ws map exceeds the guaranteed workspace");

constexpr int RING_OFF = 0, RING_BYTES = 131072;
constexpr int LDS_BYTES = 155648;
constexpr int MISC_OFF = LDS_BYTES - 256;
constexpr int TR_SCR_BYTES = 64 * 65 * 4;
static_assert(NWAVES * TR_SCR_BYTES <= MISC_OFF, "LDS map");

#define GAS __attribute__((address_space(1)))
#define LAS __attribute__((address_space(3)))
#define DI __device__ __forceinline__
typedef unsigned short bf16;
typedef unsigned u32x4 __attribute__((ext_vector_type(4)));
typedef unsigned u32x2 __attribute__((ext_vector_type(2)));
typedef float f32x4 __attribute__((ext_vector_type(4)));
typedef float f32x16 __attribute__((ext_vector_type(16)));
typedef short bf16x8 __attribute__((ext_vector_type(8)));
typedef GAS unsigned gu32;
#define RLX_AGENT __ATOMIC_RELAXED, __HIP_MEMORY_SCOPE_AGENT
#define LDS_WAIT() asm volatile("s_waitcnt lgkmcnt(0)" ::: "memory")
#define VM_WAIT() asm volatile("s_waitcnt vmcnt(0)" ::: "memory")
#define LAUNDER_V(x) asm volatile("" : "+v"(x))
#define LAUNDER_S(x) asm volatile("" : "+s"(x))
using pg8::pk2;
DI float bf_lo(unsigned w) { return __uint_as_float(w << 16); }
DI float bf_hi(unsigned w) { return __uint_as_float(w & 0xffff0000u); }
template <int CTRL> DI float dppf(float x) { return __builtin_bit_cast(float, __builtin_amdgcn_mov_dpp(__builtin_bit_cast(int, x), CTRL, 0xf, 0xf, true)); }
DI float wave_sum(float v) {
    v += dppf<0xB1>(v); v += dppf<0x4E>(v); v += dppf<0x141>(v); v += dppf<0x140>(v);
    const auto s = __builtin_amdgcn_permlane16_swap(__float_as_uint(v), __float_as_uint(v), false, false); v = __uint_as_float(s[0]) + __uint_as_float(s[1]);
    const auto t = __builtin_amdgcn_permlane32_swap(__float_as_uint(v), __float_as_uint(v), false, false); return __uint_as_float(t[0]) + __uint_as_float(t[1]);
}
DI float wave_max(float v) {
    v = fmaxf(v, dppf<0xB1>(v)); v = fmaxf(v, dppf<0x4E>(v)); v = fmaxf(v, dppf<0x141>(v)); v = fmaxf(v, dppf<0x140>(v));
    const auto s = __builtin_amdgcn_permlane16_swap(__float_as_uint(v), __float_as_uint(v), false, false); v = fmaxf(__uint_as_float(s[0]), __uint_as_float(s[1]));
    const auto t = __builtin_amdgcn_permlane32_swap(__float_as_uint(v), __float_as_uint(v), false, false); return fmaxf(__uint_as_float(t[0]), __uint_as_float(t[1]));
}

#define XB_TMO      128
#define XB_XCNT(j)  (256  + 64 * (j))
#define XB_XSUB(j)  (1280 + 64 * (j))
#define XB_XGEN(j)  (2304 + 64 * (j))
#define XB_TOP      3328
#define XB_TOPGEN   3392
#define XCD_BAR_WORDS 3456
#define XB_SPIN_CAP (1u << 18)

__device__ __forceinline__ unsigned xb_ld(unsigned* p)              { return __hip_atomic_load(p, __ATOMIC_RELAXED, __HIP_MEMORY_SCOPE_AGENT); }
__device__ __forceinline__ unsigned xb_add(unsigned* p, unsigned v) { return __hip_atomic_fetch_add(p, v, __ATOMIC_RELAXED, __HIP_MEMORY_SCOPE_AGENT); }
__device__ __forceinline__ unsigned xb_xcc_id() { return (unsigned)__builtin_amdgcn_s_getreg((3 << 11) | 20) & 0xFu; }
#define XB_SPIN(cond, bar) do { unsigned _sp = 0; while (cond) { __builtin_amdgcn_s_sleep(1); \
    if ((++_sp & 255u) == 0u) { if (xb_ld(&(bar)[XB_TMO])) break; if (_sp > XB_SPIN_CAP) { atomicAdd(&(bar)[XB_TMO], 1u); break; } } } } while (0)

struct XcdBarrier {
    unsigned* bar; unsigned x;
    volatile LAS unsigned* st;
};

__device__ __forceinline__ XcdBarrier xcd_barrier_post(unsigned* bar, volatile LAS unsigned* st) {
    XcdBarrier b; b.bar = bar; b.x = xb_xcc_id(); b.st = st;
    if (threadIdx.x == 0) (void)xb_add(&bar[XB_XCNT(b.x)], 1u);
    return b;
}
__device__ __forceinline__ void xcd_barrier_complete(unsigned* bar, unsigned x, unsigned& nloc, unsigned& nx) {
    const unsigned G = gridDim.x * gridDim.y * gridDim.z;
    unsigned sum, cnt, mine, sp = 0u;
    for (;;) {
        sum = 0u; cnt = 0u; mine = 0u;
#pragma unroll
        for (unsigned j = 0; j < 16; ++j) { const unsigned c = xb_ld(&bar[XB_XCNT(j)]); sum += c; cnt += (c > 0u) ? 1u : 0u; mine = (j == x) ? c : mine; }
        if (sum == G) break;
        __builtin_amdgcn_s_sleep(1);
        if ((++sp & 255u) == 0u) { if (xb_ld(&bar[XB_TMO])) break; if (sp > XB_SPIN_CAP) { atomicAdd(&bar[XB_TMO], 1u); break; } }
    }
    nloc = mine > 0u ? mine : 1u; nx = cnt > 0u ? cnt : 1u;
}

__device__ __forceinline__ void xcd_barrier(const XcdBarrier& b) {
    asm volatile("s_waitcnt vmcnt(0)" ::: "memory");
    __syncthreads();
    if (threadIdx.x == 0) {
        unsigned* bar = b.bar;
        __builtin_amdgcn_s_waitcnt(0);
        unsigned nloc = b.st[0], nx = b.st[1];
        if (nloc == 0u) { xcd_barrier_complete(bar, b.x, nloc, nx); b.st[0] = nloc; b.st[1] = nx; }
        const unsigned old = xb_add(&bar[XB_XSUB(b.x)], 1u);
        const unsigned gen = old / nloc;
        if (old + 1u == (gen + 1u) * nloc) {
            __builtin_amdgcn_fence(__ATOMIC_RELEASE, "agent");
            asm volatile("s_waitcnt vmcnt(0)" ::: "memory");
            const unsigned og = xb_add(&bar[XB_TOP], 1u);
            const unsigned tg = og / nx;
            if (og + 1u == (tg + 1u) * nx) xb_add(&bar[XB_TOPGEN], 1u);
            else XB_SPIN(xb_ld(&bar[XB_TOPGEN]) == tg, bar);
            __builtin_amdgcn_fence(__ATOMIC_ACQUIRE, "agent");
            xb_add(&bar[XB_XGEN(b.x)], 1u);
            asm volatile("s_waitcnt vmcnt(0)" ::: "memory");
        } else {
            XB_SPIN(xb_ld(&bar[XB_XGEN(b.x)]) == gen, bar);
            __builtin_amdgcn_fence(__ATOMIC_ACQUIRE, "agent");
            asm volatile("s_waitcnt vmcnt(0)" ::: "memory");
        }
    }
    __syncthreads();
}


#ifndef TR_NT
#define TR_NT 0
#endif
DI void tr_item(const float* W, const float* gk, int K, int N, bf16* WT, int kind, LAS float* scr, int item, int lane) {
    const int nblk = N >> 6, kb = item / nblk, nb = item - kb * nblk, k0 = kb << 6, n0 = nb << 6;
    const int kr = lane >> 4, nq = lane & 15;
    const float* src = W + (size_t)(k0 + kr) * N + n0 + 4 * nq;
#pragma unroll
    for (int i = 0; i < 16; ++i) { const f32x4 v = TR_NT ? __builtin_nontemporal_load((const f32x4*)(src + (size_t)(4 * i) * N)) : *(const f32x4*)(src + (size_t)(4 * i) * N); const float g = gk ? gk[k0 + 4 * i + kr] : 1.0f;
        LAS float* d = scr + (4 * i + kr) * 65 + 4 * nq; d[0] = v.x * g; d[1] = v.y * g; d[2] = v.z * g; d[3] = v.w * g; }
    LDS_WAIT();
    const int c = lane & 7, nn = lane >> 3;
    const int drow0 = kind == 0 ? n0 : (256 * (n0 >> 7) + (n0 & 127) + (kind == 2 ? 128 : 0));
#pragma unroll
    for (int j = 0; j < 8; ++j) { const int n = nn + 8 * j; const LAS float* s = scr + (8 * c) * 65 + n;
        u32x4 o; o.x = pk2(s[0 * 65], s[1 * 65]); o.y = pk2(s[2 * 65], s[3 * 65]); o.z = pk2(s[4 * 65], s[5 * 65]); o.w = pk2(s[6 * 65], s[7 * 65]);
        *(u32x4*)(WT + (size_t)(drow0 + n) * K + k0 + 8 * c) = o; }
    LDS_WAIT();
}
DI void tr_matrix(const float* W, const float* gk, int K, int N, bf16* WT, int kind, LAS float* scr, int gw, int NGW, int lane, int& off) {
    const int nitems = (K >> 6) * (N >> 6);
    int first = gw - off; if (first < 0) first += NGW;
    for (int it = first; it < nitems; it += NGW) tr_item(W, gk, K, N, WT, kind, scr, it, lane);
    off = (off + nitems) % NGW;
}

DI void xin_phase(const GAS float* xin, GAS bf16* x16, GAS float* ssq, int gw, int NGW, int lane) {
    for (int m = gw; m < MTOK; m += NGW) {
        const GAS f32x4* xr = (const GAS f32x4*)(xin + (size_t)m * DM) + lane;
        f32x4 v[8]; float ss = 0.f;
#pragma unroll
        for (int j = 0; j < 8; ++j) { v[j] = xr[64 * j]; ss += (v[j].x * v[j].x + v[j].y * v[j].y) + (v[j].z * v[j].z + v[j].w * v[j].w); }
        ss = wave_sum(ss);
        if (lane < 8) ssq[(size_t)m * 8 + lane] = lane == 0 ? ss : 0.f;
        GAS u32x2* d0 = (GAS u32x2*)(x16 + (size_t)m * DM) + lane;
#pragma unroll
        for (int j = 0; j < 8; ++j) { u32x2 o; o.x = pk2(v[j].x, v[j].y); o.y = pk2(v[j].z, v[j].w); d0[64 * j] = o; }
    }
}
DI void kvnorm_phase(const GAS bf16* x16, GAS bf16* hp0, GAS bf16* hp1, GAS bf16* hp2, int gw, int NGW, int lane) {
    for (int m = gw; m < MTOK; m += NGW) {
        const GAS u32x4* xr = (const GAS u32x4*)(x16 + (size_t)m * DM) + lane;
        u32x4 w[4]; float ss = 0.f;
#pragma unroll
        for (int j = 0; j < 4; ++j) { w[j] = xr[64 * j];
            float f; f = bf_lo(w[j].x); ss += f * f; f = bf_hi(w[j].x); ss += f * f; f = bf_lo(w[j].y); ss += f * f; f = bf_hi(w[j].y); ss += f * f;
            f = bf_lo(w[j].z); ss += f * f; f = bf_hi(w[j].z); ss += f * f; f = bf_lo(w[j].w); ss += f * f; f = bf_hi(w[j].w); ss += f * f; }
        ss = wave_sum(ss);
        const float rstd = 1.0f / sqrtf(ss * (1.0f / DM) + EPS);
        u32x4 o[4];
#pragma unroll
        for (int j = 0; j < 4; ++j) { o[j].x = pk2(bf_lo(w[j].x) * rstd, bf_hi(w[j].x) * rstd); o[j].y = pk2(bf_lo(w[j].y) * rstd, bf_hi(w[j].y) * rstd);
            o[j].z = pk2(bf_lo(w[j].z) * rstd, bf_hi(w[j].z) * rstd); o[j].w = pk2(bf_lo(w[j].w) * rstd, bf_hi(w[j].w) * rstd); }
        const int b = m / SEQ, t = m % SEQ;
        const int m1 = b * SEQ + (t & 3) * (SEQ / 4) + (t >> 2), m2 = b * SEQ + (t & 15) * (SEQ / 16) + (t >> 4);
        GAS u32x4* d0 = (GAS u32x4*)(hp0 + (size_t)m * DM) + lane; GAS u32x4* d1 = (GAS u32x4*)(hp1 + (size_t)m1 * DM) + lane; GAS u32x4* d2 = (GAS u32x4*)(hp2 + (size_t)m2 * DM) + lane;
#pragma unroll
        for (int j = 0; j < 4; ++j) { d0[64 * j] = o[j]; d1[64 * j] = o[j]; d2[64 * j] = o[j]; }
    }
}
DI void combine_phase(const GAS bf16* OG, const GAS float* LG, GAS bf16* O, int gw, int NGW, int lane) {
    for (int m = gw; m < MTOK; m += NGW) {
#pragma unroll
        for (int j = 0; j < 4; ++j) {
            const int c = lane + 64 * j, h = c >> 4;
            float acc[8] = {0.f, 0.f, 0.f, 0.f, 0.f, 0.f, 0.f, 0.f}; float l = 0.f;
#pragma unroll
            for (int g = 0; g < NGRP; ++g) {
                const u32x4 w = ((const GAS u32x4*)(OG + ((size_t)g * MTOK + m) * DM))[c];
                l += LG[((size_t)g * MTOK + m) * NH + h];
                acc[0] += bf_lo(w.x); acc[1] += bf_hi(w.x); acc[2] += bf_lo(w.y); acc[3] += bf_hi(w.y); acc[4] += bf_lo(w.z); acc[5] += bf_hi(w.z); acc[6] += bf_lo(w.w); acc[7] += bf_hi(w.w);
            }
            const float r = 1.0f / l;
            u32x4 o; o.x = pk2(acc[0] * r, acc[1] * r); o.y = pk2(acc[2] * r, acc[3] * r); o.z = pk2(acc[4] * r, acc[5] * r); o.w = pk2(acc[6] * r, acc[7] * r);
            ((GAS u32x4*)(O + (size_t)m * DM))[c] = o;
        }
    }
}

DI void spatial_phase(const GAS bf16* U, const GAS bf16* VTg, GAS bf16* GATED, const GAS bf16* wsb, const GAS float* vg, const GAS float* bs, LAS unsigned char* lds, int G, int tid, int wave, int lane) {
    LAS float* red = (LAS float*)lds; LAS float* rstd = (LAS float*)(lds + 16384);
    const int q32 = lane & 31, hh = lane >> 5;
    for (int unit = blockIdx.x; unit < 256; unit += G) {
        const int n = unit >> 1, hf = unit & 1; const size_t tok0 = (size_t)n * 128;
        {
            const int o = tid & 15, cl = tid >> 4; float a8[8] = {0.f, 0.f, 0.f, 0.f, 0.f, 0.f, 0.f, 0.f};
            const GAS bf16* p = VTg + (size_t)cl * MTOK + tok0 + 8 * o;
#pragma unroll 16
            for (int i = 0; i < 64; ++i) { const u32x4 w = *(const GAS u32x4*)(p + (size_t)(32 * i) * MTOK);
                float f; f = bf_lo(w.x); a8[0] += f * f; f = bf_hi(w.x); a8[1] += f * f; f = bf_lo(w.y); a8[2] += f * f; f = bf_hi(w.y); a8[3] += f * f;
                f = bf_lo(w.z); a8[4] += f * f; f = bf_hi(w.z); a8[5] += f * f; f = bf_lo(w.w); a8[6] += f * f; f = bf_hi(w.w); a8[7] += f * f; }
            __syncthreads();
#pragma unroll
            for (int e = 0; e < 8; ++e) red[cl * 128 + 8 * o + e] = a8[e];
            __syncthreads();
            if (tid < 128) { float s = 0.f;
#pragma unroll 8
                for (int i = 0; i < 32; ++i) s += red[i * 128 + tid];
                rstd[tid] = 1.0f / sqrtf(s * (1.0f / DM) + EPS); }
            __syncthreads();
        }
        const int ct = wave & 3, pt0 = (wave >> 2) * 2;
        const int ns = 2 * pt0 + 4;
        const int p0 = 32 * pt0 + q32, p1 = p0 + 32;
#pragma unroll 1
        for (int gi = 0; gi < 8; ++gi) {
            const int g = hf * 8 + gi;
            const GAS bf16* ap = VTg + (size_t)(g * 128 + 32 * ct + q32) * MTOK + tok0 + 8 * hh;
            const GAS bf16* bp0 = wsb + ((size_t)g * 128 + p0) * 128 + 8 * hh;
            const GAS bf16* bp1 = bp0 + 32 * 128;
            u32x4 af[8], b0[8], b1[8];
#pragma unroll
            for (int s = 0; s < 8; ++s) if (s < ns) { af[s] = *(const GAS u32x4*)(ap + 16 * s); b0[s] = *(const GAS u32x4*)(bp0 + 16 * s); b1[s] = *(const GAS u32x4*)(bp1 + 16 * s); }
            const float bb0 = bs[g * 128 + p0], bb1 = bs[g * 128 + p1];
            u32x2 uw0[4], uw1[4]; f32x4 gv[4];
#pragma unroll
            for (int rq = 0; rq < 4; ++rq) { const int ch = g * 128 + 32 * ct + 8 * rq + 4 * hh;
                gv[rq] = *(const GAS f32x4*)(vg + ch); uw0[rq] = *(const GAS u32x2*)(U + (tok0 + p0) * DM + ch); uw1[rq] = *(const GAS u32x2*)(U + (tok0 + p1) * DM + ch); }
            f32x16 acc0, acc1;
#pragma unroll
            for (int i = 0; i < 16; ++i) { acc0[i] = 0.f; acc1[i] = 0.f; }
#pragma unroll
            for (int s = 0; s < 8; ++s) if (s < ns) {
                const int qb = 16 * s + 8 * hh;
                const f32x4 r0 = *(const LAS f32x4*)(rstd + qb), r1 = *(const LAS f32x4*)(rstd + qb + 4);
                const float rs[8] = {r0.x, r0.y, r0.z, r0.w, r1.x, r1.y, r1.z, r1.w};
                {   const u32x4 w = b0[s];
                    float f[8] = {bf_lo(w.x), bf_hi(w.x), bf_lo(w.y), bf_hi(w.y), bf_lo(w.z), bf_hi(w.z), bf_lo(w.w), bf_hi(w.w)};
#pragma unroll
                    for (int e = 0; e < 8; ++e) f[e] = (qb + e <= p0) ? f[e] * rs[e] : 0.f;
                    u32x4 o; o.x = pk2(f[0], f[1]); o.y = pk2(f[2], f[3]); o.z = pk2(f[4], f[5]); o.w = pk2(f[6], f[7]);
                    acc0 = __builtin_amdgcn_mfma_f32_32x32x16_bf16(__builtin_bit_cast(bf16x8, af[s]), __builtin_bit_cast(bf16x8, o), acc0, 0, 0, 0); }
                {   const u32x4 w = b1[s];
                    float f[8] = {bf_lo(w.x), bf_hi(w.x), bf_lo(w.y), bf_hi(w.y), bf_lo(w.z), bf_hi(w.z), bf_lo(w.w), bf_hi(w.w)};
#pragma unroll
                    for (int e = 0; e < 8; ++e) f[e] = (qb + e <= p1) ? f[e] * rs[e] : 0.f;
                    u32x4 o; o.x = pk2(f[0], f[1]); o.y = pk2(f[2], f[3]); o.z = pk2(f[4], f[5]); o.w = pk2(f[6], f[7]);
                    acc1 = __builtin_amdgcn_mfma_f32_32x32x16_bf16(__builtin_bit_cast(bf16x8, af[s]), __builtin_bit_cast(bf16x8, o), acc1, 0, 0, 0); }
            }
#pragma unroll
            for (int rq = 0; rq < 4; ++rq) {
                const int ch = g * 128 + 32 * ct + 8 * rq + 4 * hh;
                {   u32x2 o; o.x = pk2(bf_lo(uw0[rq].x) * (acc0[4 * rq + 0] * gv[rq].x + bb0), bf_hi(uw0[rq].x) * (acc0[4 * rq + 1] * gv[rq].y + bb0));
                    o.y = pk2(bf_lo(uw0[rq].y) * (acc0[4 * rq + 2] * gv[rq].z + bb0), bf_hi(uw0[rq].y) * (acc0[4 * rq + 3] * gv[rq].w + bb0));
                    *(GAS u32x2*)(GATED + (tok0 + p0) * DM + ch) = o; }
                {   u32x2 o; o.x = pk2(bf_lo(uw1[rq].x) * (acc1[4 * rq + 0] * gv[rq].x + bb1), bf_hi(uw1[rq].x) * (acc1[4 * rq + 1] * gv[rq].y + bb1));
                    o.y = pk2(bf_lo(uw1[rq].y) * (acc1[4 * rq + 2] * gv[rq].z + bb1), bf_hi(uw1[rq].y) * (acc1[4 * rq + 3] * gv[rq].w + bb1));
                    *(GAS u32x2*)(GATED + (tok0 + p1) * DM + ch) = o; }
            }
        }
    }
    __syncthreads();
}

#ifndef PROBE_ATT_REP
#define PROBE_ATT_REP 0
#endif
#ifndef ATT_STAGGER
#define ATT_STAGGER 0
#endif
#ifndef ATT_QNT
#define ATT_QNT 0
#endif
template <int FIXED = 0> DI void attn_phase(const GAS bf16* Q, const GAS bf16* KB, const GAS bf16* VT, GAS bf16* O, const GAS float* qn, const GAS float* kn, LAS unsigned char* lds, int G, int wave, int lane) {
    float mq = 0.f, mk = 0.f;
    for (int i = lane; i < NGRP * HD; i += 64) { mq = fmaxf(mq, fabsf(qn[i])); mk = fmaxf(mk, fabsf(kn[i])); }
    mq = wave_max(mq); mk = wave_max(mk);
    const float cref = fminf(11.313708499f * mq * mk, 40.0f) * LOG2E;
    LAS float* Ls = (LAS float*)(lds + 131072);
    static_assert(ATT_STAGGER == 0, "the hand-over flags below assume the group order dilation 16, 4, 1");
    volatile LAS unsigned* FL = (volatile LAS unsigned*)(lds + 131072 + 4096);
    if (wave == 0 && lane < 48) FL[lane] = 0u;
    unsigned seq = 0u;
    __syncthreads();
    for (int task0 = blockIdx.x; task0 < 512 * (1 + (PROBE_ATT_REP ? 1 : 0)); task0 += G) { const int task = task0 & 511;
        const int wsel = task & 255, nrd = task >> 8, bh = (wsel & 7) * 8 + nrd * 4 + (wsel >> 6), B = (wsel >> 3) & 7, b = bh >> 4, h = bh & 15;
        ++seq;
        const int gshift = ATT_STAGGER ? (wsel >> 6) % 3 : 0;
#pragma unroll 1
        for (int j = 0; j < 6; ++j) {
        const bool skip_epi = (PROBE_ATT_REP == 3 && task0 >= 512);
        int lane_l = lane; LAUNDER_V(lane_l);
        const int q32 = lane_l & 31, hh = lane_l >> 5;
        const int gi = j >> 1, g = (2 - gi + gshift) % 3, w16 = 8 * (j & 1) + wave;
        const int dsh = 2 * g, dil = 1 << dsh, L = SEQ >> dsh;
        const int r = w16 >> (4 - dsh), il = 32 * (w16 & ((16 >> dsh) - 1));
        const int i0 = (512 >> dsh) * B + il;
        const int trow = r + dil * (il + q32);
        const size_t tokbase = (size_t)b * SEQ + r;
        const int colq = g * (NH * HD) + h * HD + 8 * hh;
        const int kt0 = (i0 >> 5) >= 4 ? 0 : 4 - (i0 >> 5);
        const int tmask = (PROBE_ATT_REP >= 2 && task0 >= 512) ? 1 : -1; const int tile0 = ((b * SEQ + r * L) >> 5) + (i0 >> 5) - 4;
        const GAS bf16* kblk = KB + (((size_t)g * NH + h) * 512) * 4096 + q32 * 16 + 8 * hh;
        const GAS bf16* vblk = VT + (((size_t)g * NH + h) * 512) * 4096 + q32 * 16 + 8 * hh;
        u32x4 kb0[8], kb1[8], kb2[8];
        const int rot = (9 - ((i0 >> 5) % 5)) % 5;
#define KT(i) (((i) + rot) >= 5 ? ((i) + rot) - 5 : ((i) + rot))
#define ATT_LOADK(buf, kt) do { const GAS bf16* kp_ = kblk + (size_t)((tile0 + ((kt) > kt0 ? (kt) : kt0)) & tmask) * 4096; _Pragma("unroll") for (int s_ = 0; s_ < 8; ++s_) buf[s_] = *(const GAS u32x4*)(kp_ + 512 * s_); } while (0)
        u32x4 w[8];
        {   const GAS bf16* qrow = Q + (tokbase + (size_t)dil * (i0 + q32)) * QW + colq;
#pragma unroll
            for (int s = 0; s < 8; ++s) w[s] = ATT_QNT ? __builtin_nontemporal_load((const GAS u32x4*)(qrow + 16 * s)) : *(const GAS u32x4*)(qrow + 16 * s);
        }
        ATT_LOADK(kb0, KT(0)); ATT_LOADK(kb1, KT(1)); ATT_LOADK(kb2, KT(2));
        bf16x8 qf[8];
        {   float ss = 0.f;
#pragma unroll
            for (int s = 0; s < 8; ++s) {
                float f; f = bf_lo(w[s].x); ss += f * f; f = bf_hi(w[s].x); ss += f * f; f = bf_lo(w[s].y); ss += f * f; f = bf_hi(w[s].y); ss += f * f;
                f = bf_lo(w[s].z); ss += f * f; f = bf_hi(w[s].z); ss += f * f; f = bf_lo(w[s].w); ss += f * f; f = bf_hi(w[s].w); ss += f * f; }
            { const auto t_ = __builtin_amdgcn_permlane32_swap(__float_as_uint(ss), __float_as_uint(ss), false, false); ss = __uint_as_float(t_[0]) + __uint_as_float(t_[1]); }
            const float rs = (1.0f / sqrtf(ss * (1.0f / HD) + EPS)) * (0.08838834764831845f * LOG2E);
#pragma unroll
            for (int s = 0; s < 8; ++s) { const GAS float* gp = qn + g * HD + 16 * s + 8 * hh; const f32x4 g0 = *(const GAS f32x4*)gp, g1 = *(const GAS f32x4*)(gp + 4);
                u32x4 o; o.x = pk2(bf_lo(w[s].x) * rs * g0.x, bf_hi(w[s].x) * rs * g0.y); o.y = pk2(bf_lo(w[s].y) * rs * g0.z, bf_hi(w[s].y) * rs * g0.w);
                o.z = pk2(bf_lo(w[s].z) * rs * g1.x, bf_hi(w[s].z) * rs * g1.y); o.w = pk2(bf_lo(w[s].w) * rs * g1.z, bf_hi(w[s].w) * rs * g1.w);
                qf[s] = __builtin_bit_cast(bf16x8, o); }
        }
        const float sl2 = __builtin_amdgcn_exp2f(-0.5f * (float)(h + 1)) * (float)dil * LOG2E;
        float lsum = 0.f;
        u32x4 pk[5][2];
#define ATT_SCORE(buf, i) do { { f32x16 st_; const int kt_ = KT(i); \
            int dbase_ = q32 + 128 - 32 * kt_ - 4 * hh; LAUNDER_V(dbase_);        \
            float nb_ = -fmaf(sl2, (float)dbase_, cref); nb_ = (kt_ >= kt0) ? nb_ : -1e30f;        \
            _Pragma("unroll") for (int rg_ = 0; rg_ < 16; ++rg_) { const int c_ = (rg_ & 3) + 8 * (rg_ >> 2); const float v_ = fmaf((float)c_, sl2, nb_); \
                st_[rg_] = ((unsigned)(dbase_ - c_) <= 128u) ? v_ : -1e30f; }                    \
            _Pragma("unroll") for (int s_ = 0; s_ < 8; ++s_) st_ = __builtin_amdgcn_mfma_f32_32x32x16_bf16(__builtin_bit_cast(bf16x8, buf[s_]), qf[s_], st_, 0, 0, 0); \
            if ((i) + 3 < 5) ATT_LOADK(buf, KT((i) + 3)); \
            float p_[16]; \
            _Pragma("unroll") for (int rg_ = 0; rg_ < 16; ++rg_) { p_[rg_] = __builtin_amdgcn_exp2f(st_[rg_]); lsum += p_[rg_]; } \
            _Pragma("unroll") for (int s2_ = 0; s2_ < 2; ++s2_) { pk[i][s2_].x = pk2(p_[8 * s2_ + 0], p_[8 * s2_ + 1]); pk[i][s2_].y = pk2(p_[8 * s2_ + 2], p_[8 * s2_ + 3]); \
                pk[i][s2_].z = pk2(p_[8 * s2_ + 4], p_[8 * s2_ + 5]); pk[i][s2_].w = pk2(p_[8 * s2_ + 6], p_[8 * s2_ + 7]); } \
        } } while (0)
#define ATT_LOADV(buf, kt) do { const GAS bf16* vp_ = vblk + (size_t)((tile0 + ((kt) > kt0 ? (kt) : kt0)) & tmask) * 4096; _Pragma("unroll") for (int i_ = 0; i_ < 8; ++i_) buf[i_] = *(const GAS u32x4*)(vp_ + 512 * i_); } while (0)
        ATT_SCORE(kb0, 0); ATT_SCORE(kb1, 1); ATT_SCORE(kb2, 2); ATT_LOADV(kb2, KT(0));
        ATT_SCORE(kb0, 3); ATT_LOADV(kb0, KT(1)); ATT_SCORE(kb1, 4); ATT_LOADV(kb1, KT(2));
        f32x16 ot[4];
#pragma unroll
        for (int dt = 0; dt < 4; ++dt)
#pragma unroll
            for (int i = 0; i < 16; ++i) ot[dt][i] = 0.f;
#define ATT_PV(buf, i) do { { _Pragma("unroll") for (int dt_ = 0; dt_ < 4; ++dt_) _Pragma("unroll") for (int s2_ = 0; s2_ < 2; ++s2_) \
            ot[dt_] = __builtin_amdgcn_mfma_f32_32x32x16_bf16(__builtin_bit_cast(bf16x8, buf[2 * dt_ + s2_]), __builtin_bit_cast(bf16x8, pk[i][s2_]), ot[dt_], 0, 0, 0); \
            if ((i) + 3 < 5) ATT_LOADV(buf, KT((i) + 3)); } } while (0)
        ATT_PV(kb2, 0); ATT_PV(kb0, 1); ATT_PV(kb1, 2); ATT_PV(kb2, 3); ATT_PV(kb0, 4);
#undef KT
#undef ATT_LOADK
#undef ATT_SCORE
#undef ATT_LOADV
#undef ATT_PV
        { const auto t_ = __builtin_amdgcn_permlane32_swap(__float_as_uint(lsum), __float_as_uint(lsum), false, false); lsum = __uint_as_float(t_[0]) + __uint_as_float(t_[1]); }
        if (skip_epi) { asm volatile("" :: "v"(ot[0]), "v"(ot[1]), "v"(ot[2]), "v"(ot[3]), "v"(lsum)); continue; }
        if (gi > 0) {
#pragma unroll 1
            for (int k = 0; k < 4; ++k) { const int fi_ = gi == 1 ? (w16 >> 2) + 4 * k : 16 + 4 * k + (w16 >> 2); while (FL[fi_] < seq) __builtin_amdgcn_s_sleep(1); }
            asm volatile("" ::: "memory"); }
        else {
#pragma unroll 1
            for (int k = 0; k < 16; ++k) while (FL[32 + k] + 1u < seq) __builtin_amdgcn_s_sleep(1);
            asm volatile("" ::: "memory"); }
        const int hsh = (trow ^ (trow >> 2) ^ (trow >> 4)) & 15;
        LAS unsigned char* srow = lds + trow * 256;
        float rinv = 1.0f;
        if (gi < 2) { if (hh == 0) Ls[gi * 512 + trow] = lsum; }
        else rinv = 1.0f / (lsum + Ls[trow] + Ls[512 + trow]);
        GAS bf16* op = O + (PROBE_ATT_REP && task0 >= 512 ? (size_t)48 * MiB : (size_t)0) + (tokbase + (size_t)dil * (i0 + q32)) * DM + h * HD + 8 * hh;
#pragma unroll
        for (int dt = 0; dt < 4; ++dt)
#pragma unroll
            for (int pr = 0; pr < 2; ++pr) { const int r0 = 8 * pr, r1 = 8 * pr + 4;
                const unsigned a0 = pk2(ot[dt][r0 + 0], ot[dt][r0 + 1]), a1 = pk2(ot[dt][r0 + 2], ot[dt][r0 + 3]), b0 = pk2(ot[dt][r1 + 0], ot[dt][r1 + 1]), b1 = pk2(ot[dt][r1 + 2], ot[dt][r1 + 3]);
                const auto s0 = __builtin_amdgcn_permlane32_swap(a0, b0, false, false); const auto s1 = __builtin_amdgcn_permlane32_swap(a1, b1, false, false);
                u32x4 o; o.x = s0[0]; o.y = s1[0]; o.z = s0[1]; o.w = s1[1];
                LAS u32x4* sp = (LAS u32x4*)(srow + (((4 * dt + 2 * pr + hh) ^ hsh) << 4));
                if (gi == 0) *sp = o;
                else { const u32x4 a = *sp;
                    const float f0 = bf_lo(a.x) + bf_lo(o.x), f1 = bf_hi(a.x) + bf_hi(o.x), f2 = bf_lo(a.y) + bf_lo(o.y), f3 = bf_hi(a.y) + bf_hi(o.y);
                    const float f4 = bf_lo(a.z) + bf_lo(o.z), f5 = bf_hi(a.z) + bf_hi(o.z), f6 = bf_lo(a.w) + bf_lo(o.w), f7 = bf_hi(a.w) + bf_hi(o.w);
                    u32x4 w; w.x = pk2(f0 * rinv, f1 * rinv); w.y = pk2(f2 * rinv, f3 * rinv); w.z = pk2(f4 * rinv, f5 * rinv); w.w = pk2(f6 * rinv, f7 * rinv);
                    if (gi == 1) *sp = w; else *(GAS u32x4*)(op + 32 * dt + 16 * pr) = w; } }
        asm volatile("s_waitcnt lgkmcnt(0)" ::: "memory"); if (lane_l == 0) FL[16 * gi + w16] = seq;
        }
    }
}

#ifndef PROBE_DUP_ATTN
#define PROBE_DUP_ATTN 0
#endif
struct Args { const float* in[21]; float* out; unsigned char* ws; int ph_lo, ph_hi; };
typedef __attribute__((address_space(4))) Args KArgs;
__global__ void __launch_bounds__(NWAVES * 64, 2) yoco_fwd(Args args) {
    extern __shared__ __attribute__((aligned(16))) unsigned char lds_raw[];
    LAS unsigned char* lds = (LAS unsigned char*)lds_raw;
    volatile LAS unsigned* MISC = (volatile LAS unsigned*)(lds + MISC_OFF);
    const int tid0 = threadIdx.x;
    const int wave0 = __builtin_amdgcn_readfirstlane(tid0 >> 6);
    const int G = gridDim.x, NGW = G * NWAVES;
    if (tid0 < 64) MISC[tid0] = 0u;
    __syncthreads();
    XcdBarrier bar; bar.bar = (unsigned*)(args.ws + WS_CTL) + 1024; bar.x = 0; bar.st = nullptr;
    if (!MK_PER_PHASE) bar = xcd_barrier_post((unsigned*)(args.ws + WS_CTL) + 1024, MISC + 8);
    const int lo = args.ph_lo, hi = args.ph_hi;
    int pc = 0;
#define PH_ON (pc >= lo && pc < hi)
#define PH_END do { if (!MK_PER_PHASE && pc >= lo && pc + 1 < hi) { XcdBarrier b_ = bar; LAUNDER_S(b_.bar); xcd_barrier(b_); } ++pc; } while (0)
#define PH_VARS int tid; asm volatile("v_mbcnt_lo_u32_b32 %0, -1, 0\n\tv_mbcnt_hi_u32_b32 %0, -1, %0" : "=v"(tid)); tid += wave0 * 64; const int lane = tid & 63, wave = __builtin_amdgcn_readfirstlane(tid >> 6), gw = blockIdx.x * NWAVES + wave; \
    const KArgs* ap = (const KArgs*)__builtin_amdgcn_kernarg_segment_ptr(); LAUNDER_S(ap); unsigned char* ws = ap->ws; LAUNDER_S(ws); float* X = ap->out; LAUNDER_S(X); (void)lane; (void)gw; \
    bf16* X16 = (bf16*)(ws + WS_HN); bf16* SCR = (bf16*)(ws + WS_SCR); bf16* KB = (bf16*)(ws + WS_KB); bf16* VT = (bf16*)(ws + WS_VT); (void)X16; (void)SCR; (void)KB; (void)VT; (void)X

    if (PH_ON) {
        PH_VARS;
        LAS float* scr = (LAS float*)(lds + wave * TR_SCR_BYTES);
        int off = 0;
        for (int fi = 0; fi < 8; ++fi) { const int l = fi >> 1, sec = fi & 1;
            const float* wg = ap->in[sec ? 7 : 2] + (size_t)l * DM * DFF; const float* wu = ap->in[sec ? 8 : 3] + (size_t)l * DM * DFF; const float* wd = ap->in[sec ? 9 : 4] + (size_t)l * DFF * DM;
            const float* gn = ap->in[sec ? 6 : 1] + (size_t)l * DM;
            bf16* gu = (bf16*)(ws + ws_gu(fi));
            tr_matrix(wg, gn, DM, DFF, gu, 1, scr, gw, NGW, lane, off);
            tr_matrix(wu, gn, DM, DFF, gu, 2, scr, gw, NGW, lane, off);
            tr_matrix(wd, nullptr, DFF, DM, (bf16*)(ws + ws_d(fi)), 0, scr, gw, NGW, lane, off); }
        for (int l = 0; l < 2; ++l) {
            tr_matrix(ap->in[10] + (size_t)l * DM * 4096, ap->in[5] + (size_t)l * DM, DM, 4096, (bf16*)(ws + WS_WIN) + (size_t)l * 4096 * DM, 0, scr, gw, NGW, lane, off);
            tr_matrix(ap->in[14] + (size_t)l * DM * DM, nullptr, DM, DM, (bf16*)(ws + WS_WOUT) + (size_t)l * DM * DM, 0, scr, gw, NGW, lane, off);
            tr_matrix(ap->in[18] + (size_t)l * DM * QW, ap->in[5] + (size_t)(2 + l) * DM, DM, QW, (bf16*)(ws + WS_WQ) + (size_t)l * QW * DM, 0, scr, gw, NGW, lane, off);
            tr_matrix(ap->in[20] + (size_t)l * DM * DM, nullptr, DM, DM, (bf16*)(ws + WS_WO) + (size_t)l * DM * DM, 0, scr, gw, NGW, lane, off); }
        tr_matrix(ap->in[16], ap->in[15], DM, 2 * QW, (bf16*)(ws + WS_WKV), 0, scr, gw, NGW, lane, off);
        {   const float* s = ap->in[12]; bf16* d = (bf16*)(ws + WS_WS);
            for (int i = gw * 64 + lane; i < 2 * 16 * 128 * 128 / 4; i += NGW * 64) { const f32x4 v = ((const f32x4*)s)[i]; u32x2 o; o.x = pk2(v.x, v.y); o.y = pk2(v.z, v.w); ((u32x2*)d)[i] = o; } }
        xin_phase((const GAS float*)ap->in[0], (GAS bf16*)X16, (GAS float*)(ws + WS_SSQ), gw, NGW, lane);
        __syncthreads();
    }
    PH_END;

    for (int s = 0; s < NSTEPS; ++s) {
        const bool isKV = (s == 6); const int s2 = s > 6 ? s - 1 : s; const int l = s2 / 3, kind = isKV ? 3 : s2 % 3;
        const size_t scur_off = WS_SSQ, snext_off = WS_SSQ;
        size_t rA_off = WS_SCR, rB_off = 0; int rK = DM; float rscale = 1.0f;
        if (kind == 0 || kind == 2) {
            const int fi = 2 * l + (kind == 2 ? 1 : 0);
            if (PH_ON) {
                PH_VARS;
                pg8::Gemm g{X16, (const bf16*)(ws + ws_gu(fi)), MTOK, 2 * DFF, DM}; pg8::StaticOrder S; S.init(MTOK, 2 * DFF, G, (int)blockIdx.x);
                pg8::EpiSwiGLU E{(GAS bf16*)SCR, DFF, (const float*)(ws + scur_off)};
                pg8::gemm_phase<pg8::EpiSwiGLU, pg8::StaticOrder, true, true>(lds + RING_OFF, g, S, E, tid);
            }
            PH_END;
            rA_off = WS_SCR; rB_off = ws_d(fi); rK = DFF; rscale = 0.5f;
        } else {
            int njobs; if (kind == 3) njobs = 6; else if (l < 2) njobs = 2; else njobs = 1;
            if (PH_ON) {
                for (int jb = 0; jb < njobs; ++jb) {
                    PH_VARS;
                    bf16* UU = SCR; bf16* VTG = SCR + (size_t)MTOK * DM;
                    const bf16* A; const bf16* Bt; int Mg, Ng, ldc, act; bf16* O;
                    int mode = 0, nmode = 1;
                    int dA = 0, dB = 0;
                    if (kind == 3) {
                        const int gq = jb >= 3 ? jb - 3 : jb;
                        if (jb < 3) { A = X16; dA = 2 * gq; nmode = 1; Bt = (const bf16*)(ws + WS_WKV) + (size_t)(gq * DM) * DM; Mg = MTOK; Ng = DM; O = KB + (size_t)gq * DM * MTOK; ldc = 0; act = 0; mode = 1; }
                        else { A = (const bf16*)(ws + WS_WKV) + (size_t)(QW + gq * DM) * DM; Bt = X16; dB = 2 * gq; nmode = 2; Mg = DM; Ng = MTOK; O = VT + (size_t)gq * DM * MTOK; ldc = 0; act = 0; mode = 2; }
                    } else if (l < 2) {
                        const bf16* win = (const bf16*)(ws + WS_WIN) + (size_t)l * 4096 * DM;
                        if (jb == 0) { A = X16; Bt = win; Mg = MTOK; Ng = DM; O = UU; ldc = DM; act = 1; }
                        else { A = win + (size_t)DM * DM; Bt = X16; Mg = DM; Ng = MTOK; O = VTG; ldc = MTOK; act = 1; nmode = 2; }
                    } else { A = X16; Bt = (const bf16*)(ws + WS_WQ) + (size_t)(l - 2) * QW * DM; Mg = MTOK; Ng = QW; O = SCR; ldc = QW; act = 0; }
                    pg8::Gemm g{A, Bt, Mg, Ng, DM, dA, dB}; pg8::StaticOrder S; S.init(Mg, Ng, G, (int)blockIdx.x);
                    const float* kgn = ap->in[17]; LAUNDER_S(kgn);
                    pg8::EpiBf16Rt E{(GAS bf16*)O, ldc, act, mode, nmode, (const float*)(ws + scur_off), (const GAS float*)(kgn + (kind == 3 && jb < 3 ? jb : 0) * HD), dA + dB};
                    pg8::gemm_phase<pg8::EpiBf16Rt, pg8::StaticOrder, true, true>(lds + RING_OFF, g, S, E, tid);
                }
            }
            PH_END;
            if (kind == 3) {
            } else if (l < 2) {
                if (PH_ON) { PH_VARS; bf16* UU = SCR; bf16* VTG = SCR + (size_t)MTOK * DM; bf16* GATED = SCR + (size_t)2 * MTOK * DM;
                    const float* vg = ap->in[11] + (size_t)l * DM; LAUNDER_S(vg); const float* bsp = ap->in[13] + (size_t)l * 16 * 128; LAUNDER_S(bsp);
                    spatial_phase((const GAS bf16*)UU, (const GAS bf16*)VTG, (GAS bf16*)GATED, (const GAS bf16*)(ws + WS_WS) + (size_t)l * 16 * 128 * 128, (const GAS float*)vg, (const GAS float*)bsp, lds, G, tid, wave, lane); }
                PH_END;
                rA_off = WS_SCR + (size_t)2 * MTOK * DM * 2; rB_off = WS_WOUT + (size_t)l * DM * DM * 2; rK = DM; rscale = 1.0f;
            } else {
                if (PH_ON) { PH_VARS; const float* qn = ap->in[19] + (size_t)(l - 2) * NGRP * HD; LAUNDER_S(qn); const float* kn = ap->in[17]; LAUNDER_S(kn);
                    attn_phase((const GAS bf16*)SCR, (const GAS bf16*)KB, (const GAS bf16*)VT, (GAS bf16*)(ws + WS_OG), (const GAS float*)qn, (const GAS float*)kn, lds, G, wave, lane);
#if PROBE_DUP_ATTN
                    attn_phase<PROBE_DUP_ATTN - 1>((const GAS bf16*)SCR, (const GAS bf16*)KB, (const GAS bf16*)VT, (GAS bf16*)(ws + WS_OG + 96 * MiB), (const GAS float*)qn, (const GAS float*)kn, lds, G, wave, lane);
#endif
                    }
                PH_END;
                rA_off = WS_OG; rB_off = WS_WO + (size_t)(l - 2) * DM * DM * 2; rK = DM; rscale = 1.0f;
            }
        }
        if (kind != 3) {
            if (PH_ON) {
                PH_VARS;
                pg8::Gemm g{(const bf16*)(ws + rA_off), (const bf16*)(ws + rB_off), MTOK, DM, rK}; pg8::StaticOrder S; S.init(MTOK, DM, G, (int)blockIdx.x);
                pg8::EpiResid E{(GAS bf16*)X16, DM, rscale, (s + 1 < NSTEPS) ? (GAS float*)nullptr : (GAS float*)X, (GAS float*)(ws + snext_off)};
                pg8::gemm_phase<pg8::EpiResid, pg8::StaticOrder, true, true>(lds + RING_OFF, g, S, E, tid);
            }
            PH_END;
        }
    }
#undef PH_ON
#undef PH_END
#undef PH_VARS
}

extern "C" void kernel_launch(void* const* d_in, const int* in_sizes, int n_in, void* d_out, int out_size, void* d_ws, size_t ws_size, hipStream_t stream) {
    static int grid = 0;
    if (grid == 0) {
        if (n_in != 21 || in_sizes[0] != MTOK * DM || out_size != MTOK * DM || ws_size < WS_END) { fprintf(stderr, "kernel_launch: unexpected shapes (n_in %d, in0 %d, out %d, ws %zu < %zu)\n", n_in, n_in > 0 ? in_sizes[0] : -1, out_size, ws_size, (size_t)WS_END); grid = -1; return; }
        int dev = 0, cus = 0, per_cu = 0;
        if (hipGetDevice(&dev) != hipSuccess || hipDeviceGetAttribute(&cus, hipDeviceAttributeMultiprocessorCount, dev) != hipSuccess) { grid = -1; return; }
        if (hipFuncSetAttribute((const void*)yoco_fwd, hipFuncAttributeMaxDynamicSharedMemorySize, LDS_BYTES) != hipSuccess) { fprintf(stderr, "kernel_launch: hipFuncSetAttribute failed\n"); grid = -1; return; }
        if (hipOccupancyMaxActiveBlocksPerMultiprocessor(&per_cu, (const void*)yoco_fwd, NWAVES * 64, LDS_BYTES) != hipSuccess || per_cu < 1) fprintf(stderr, "kernel_launch: occupancy query reports %d\n", per_cu);
        (void)hipGetLastError();
        grid = cus;
    }
    if (grid < 0) return;
    (void)hipMemsetAsync((char*)d_ws + WS_CTL, 0, CTL_ZERO_BYTES, stream);
    Args a{};
    for (int i = 0; i < 21; ++i) a.in[i] = (const float*)d_in[i];
    a.out = (float*)d_out; a.ws = (unsigned char*)d_ws;
#if MK_PER_PHASE
    for (int p = 0; p < NPHASES; ++p) { a.ph_lo = p; a.ph_hi = p + 1; hipLaunchKernelGGL(yoco_fwd, dim3(grid), dim3(NWAVES * 64), LDS_BYTES, stream, a); }
#else
    a.ph_lo = 0; a.ph_hi = 1 << 30;
    hipLaunchKernelGGL(yoco_fwd, dim3(grid), dim3(NWAVES * 64), LDS_BYTES, stream, a);
#endif
}
```
